# Optimizing an MI355X kernel written in HIP

```python
import jax, jax.numpy as jnp
from jax import lax
import numpy as np

D_MODEL = 1024
BATCH = 2
SEQ = 8192
DEPTH = 4
DEC_BATCH = 4
DEC_SEQ = 4096
PAST_LEN = 128

N_META = 16
N_HEADS = 16
N_KV_HEADS = 4
HEAD_DIM = 64
GQA_GROUP = N_HEADS // N_KV_HEADS
ATTN_WIDTH = N_HEADS * HEAD_DIM
KV_WIDTH = N_KV_HEADS * HEAD_DIM
WINDOW = 128
BLOCK = 128
POOL_WINDOWS = (2, 4, 8, 16)
POOL_GROUPS = len(POOL_WINDOWS)
POOL_GROUP_WIDTH = 128
POOL_WIDTH = POOL_GROUPS * POOL_GROUP_WIDTH
N_BRANCHES = 2
IN_WIDTH = ATTN_WIDTH + 2 * KV_WIDTH + POOL_WIDTH + N_BRANCHES * D_MODEL
D_FF = 4 * D_MODEL
LN_EPS = 1e-5
DEEPNORM_ALPHA = float((2 * DEPTH) ** 0.25)
DEEPNORM_BETA = float((8 * DEPTH) ** -0.25)

kernel_name = "hybrid_swa_pool_deepnorm_encoder"

F32 = jnp.float32


def layer_norm(x, g, b):
    xf = x.astype(F32)
    mu = jnp.mean(xf, axis=-1, keepdims=True)
    var = jnp.mean(jnp.square(xf - mu), axis=-1, keepdims=True)
    y = (xf - mu) * lax.rsqrt(var + LN_EPS)
    return (y * g.astype(F32) + b.astype(F32)).astype(x.dtype)


def alibi_slopes():
    return jnp.asarray(2.0 ** (-8.0 * np.arange(1, N_HEADS + 1) / N_HEADS), dtype=F32)


def windowed_gqa(q, k, v, sink):
    B, L = q.shape[0], q.shape[1]
    S = L - N_META
    nb = S // BLOCK
    scale = HEAD_DIM ** -0.5
    slopes = alibi_slopes().reshape(N_KV_HEADS, GQA_GROUP)
    sink_kg = sink.astype(F32).reshape(N_KV_HEADS, GQA_GROUP)
    qm, qr = q[:, :N_META], q[:, N_META:]
    km, kr = k[:, :N_META], k[:, N_META:]
    vm, vr = v[:, :N_META], v[:, N_META:]

    qb = qr.reshape(B, nb, BLOCK, N_KV_HEADS, GQA_GROUP, HEAD_DIM)
    pad = ((0, 0), (BLOCK, BLOCK), (0, 0), (0, 0))
    kp = jnp.pad(kr, pad).reshape(B, nb + 2, BLOCK, N_KV_HEADS, HEAD_DIM)
    vp = jnp.pad(vr, pad).reshape(B, nb + 2, BLOCK, N_KV_HEADS, HEAD_DIM)
    kband = jnp.concatenate([kp[:, :-2], kp[:, 1:-1], kp[:, 2:]], axis=2)
    vband = jnp.concatenate([vp[:, :-2], vp[:, 1:-1], vp[:, 2:]], axis=2)
    s_band = jnp.einsum('bnqkgd,bnskd->bnkgqs', qb, kband, preferred_element_type=F32) * scale
    qi = jnp.arange(BLOCK)
    si = jnp.arange(3 * BLOCK)
    rel = si[None, :] - BLOCK - qi[:, None]
    key_idx = jnp.arange(nb)[:, None] * BLOCK - BLOCK + si[None, :]
    valid = (jnp.abs(rel) <= WINDOW)[None] & ((key_idx >= 0) & (key_idx < S))[:, None, :]
    bias = -slopes[:, :, None, None] * jnp.abs(rel).astype(F32)
    s_band = jnp.where(valid[None, :, None, None], s_band + bias[None, None], -jnp.inf)
    s_meta = jnp.einsum('bnqkgd,bmkd->bnkgqm', qb, km, preferred_element_type=F32) * scale
    sink_r = jnp.broadcast_to(sink_kg[None, None, :, :, None, None],
                              (B, nb, N_KV_HEADS, GQA_GROUP, BLOCK, 1))
    p = jax.nn.softmax(jnp.concatenate([s_meta, s_band, sink_r], axis=-1), axis=-1)
    pm = p[..., :N_META].astype(v.dtype)
    pb = p[..., N_META:N_META + 3 * BLOCK].astype(v.dtype)
    out_r = (jnp.einsum('bnkgqm,bmkd->bnqkgd', pm, vm)
             + jnp.einsum('bnkgqs,bnskd->bnqkgd', pb, vband)).reshape(B, S, ATTN_WIDTH)

    qmg = qm.reshape(B, N_META, N_KV_HEADS, GQA_GROUP, HEAD_DIM)
    kf, vf = kr[:, :BLOCK], vr[:, :BLOCK]
    s_mm = jnp.einsum('bqkgd,bmkd->bkgqm', qmg, km, preferred_element_type=F32) * scale
    s_mr = jnp.einsum('bqkgd,bskd->bkgqs', qmg, kf, preferred_element_type=F32) * scale
    dist = (N_META + jnp.arange(BLOCK))[None, :] - jnp.arange(N_META)[:, None]
    s_mr = jnp.where((dist <= WINDOW)[None, None, None],
                     s_mr - slopes[None, :, :, None, None] * dist.astype(F32)[None, None, None], -jnp.inf)
    sink_m = jnp.broadcast_to(sink_kg[None, :, :, None, None], (B, N_KV_HEADS, GQA_GROUP, N_META, 1))
    pmq = jax.nn.softmax(jnp.concatenate([s_mm, s_mr, sink_m], axis=-1), axis=-1)
    out_m = (jnp.einsum('bkgqm,bmkd->bqkgd', pmq[..., :N_META].astype(v.dtype), vm)
             + jnp.einsum('bkgqs,bskd->bqkgd', pmq[..., N_META:N_META + BLOCK].astype(v.dtype), vf)
             ).reshape(B, N_META, ATTN_WIDTH)
    return jnp.concatenate([out_m, out_r], axis=1)


def multiscale_pool(u, w_grp, pool_scale):
    B, L, _ = u.shape
    uf = u.astype(F32)
    cs = jnp.pad(jnp.cumsum(uf, axis=1), ((0, 0), (1, 0), (0, 0)))
    t = jnp.arange(L)
    diffs = []
    for g, w in enumerate(POOL_WINDOWS):
        lo = jnp.clip(t - w // 2, 0, L)
        hi = jnp.clip(t + w // 2, 0, L)
        sl = slice(g * POOL_GROUP_WIDTH, (g + 1) * POOL_GROUP_WIDTH)
        csg = cs[..., sl]
        mean = (jnp.take(csg, hi, axis=1) - jnp.take(csg, lo, axis=1)) / (hi - lo).astype(F32)[None, :, None]
        diffs.append(mean - uf[..., sl])
    d = jnp.stack(diffs, axis=2).astype(u.dtype)
    y = jnp.einsum('blgc,gcd->blgd', d, w_grp).reshape(B, L, POOL_WIDTH)
    return y * pool_scale


def encoder_layer(x, w_in, sink, w_pool, pool_scale, w_bo_attn, w_bo_pool, w_out, ln1_g, ln1_b,
                  w_mlp1, b_mlp1, w_mlp2, b_mlp2, ln2_g, ln2_b):
    B, L, _ = x.shape
    proj = x @ w_in
    q, k, v, u, gates = jnp.split(
        proj, [ATTN_WIDTH, ATTN_WIDTH + KV_WIDTH, ATTN_WIDTH + 2 * KV_WIDTH,
               ATTN_WIDTH + 2 * KV_WIDTH + POOL_WIDTH], axis=-1)
    q = q.reshape(B, L, N_HEADS, HEAD_DIM)
    k = k.reshape(B, L, N_KV_HEADS, HEAD_DIM)
    v = v.reshape(B, L, N_KV_HEADS, HEAD_DIM)
    ya = windowed_gqa(q, k, v, sink) @ w_bo_attn
    yb = multiscale_pool(u, w_pool, pool_scale) @ w_bo_pool
    g = jax.nn.sigmoid(gates.astype(F32)).astype(x.dtype)
    mixed = (g[..., :D_MODEL] * ya + g[..., D_MODEL:] * yb) @ w_out
    x = layer_norm(DEEPNORM_ALPHA * x + mixed, ln1_g, ln1_b)
    h = jnp.square(jax.nn.relu(x @ w_mlp1 + b_mlp1))
    return layer_norm(DEEPNORM_ALPHA * x + (h @ w_mlp2 + b_mlp2), ln2_g, ln2_b)


def encode(x, meta_tokens, ln_emb_g, ln_emb_b, layer_params):
    B = x.shape[0]
    meta = jnp.broadcast_to(meta_tokens.astype(x.dtype)[None], (B, N_META, D_MODEL))
    h = layer_norm(jnp.concatenate([meta, x], axis=1), ln_emb_g, ln_emb_b)
    for l in range(DEPTH):
        h = encoder_layer(h, *[p[l] for p in layer_params])
    return h[:, N_META:]


def setup_inputs(seed: int = 0) -> dict:
    key = jax.random.key(seed)
    ks = jax.random.split(key, 24)
    nrm = lambda k, shape, s: jax.random.normal(k, shape, dtype=F32) * s
    return {
        "x_prompt": nrm(ks[0], (BATCH, SEQ, D_MODEL), 1.0),
        "x_sample": nrm(ks[1], (DEC_BATCH, DEC_SEQ, D_MODEL), 1.0),
        "meta_tokens": nrm(ks[2], (N_META, D_MODEL), 1.0),
        "ln_emb_g": 1.0 + nrm(ks[3], (D_MODEL,), 0.02),
        "ln_emb_b": nrm(ks[4], (D_MODEL,), 0.02),
        "w_in": nrm(ks[5], (DEPTH, D_MODEL, IN_WIDTH), D_MODEL ** -0.5),
        "sink": nrm(ks[6], (DEPTH, N_HEADS), 0.5),
        "w_pool": nrm(ks[7], (DEPTH, POOL_GROUPS, POOL_GROUP_WIDTH, POOL_GROUP_WIDTH), POOL_GROUP_WIDTH ** -0.5),
        "pool_scale": 1.0 + nrm(ks[8], (DEPTH, POOL_WIDTH), 0.02),
        "w_bo_attn": nrm(ks[9], (DEPTH, ATTN_WIDTH, D_MODEL), ATTN_WIDTH ** -0.5),
        "w_bo_pool": nrm(ks[10], (DEPTH, POOL_WIDTH, D_MODEL), POOL_WIDTH ** -0.5),
        "w_out": nrm(ks[11], (DEPTH, D_MODEL, D_MODEL), DEEPNORM_BETA * D_MODEL ** -0.5),
        "ln1_g": 1.0 + nrm(ks[12], (DEPTH, D_MODEL), 0.02),
        "ln1_b": nrm(ks[13], (DEPTH, D_MODEL), 0.02),
        "w_mlp1": nrm(ks[14], (DEPTH, D_MODEL, D_FF), D_MODEL ** -0.5),
        "b_mlp1": nrm(ks[15], (DEPTH, D_FF), 0.02),
        "w_mlp2": nrm(ks[16], (DEPTH, D_FF, D_MODEL), DEEPNORM_BETA * D_FF ** -0.5),
        "b_mlp2": nrm(ks[17], (DEPTH, D_MODEL), 0.02),
        "ln2_g": 1.0 + nrm(ks[18], (DEPTH, D_MODEL), 0.02),
        "ln2_b": nrm(ks[19], (DEPTH, D_MODEL), 0.02),
    }


def reference(x_prompt, x_sample, meta_tokens, ln_emb_g, ln_emb_b, w_in, sink, w_pool, pool_scale,
              w_bo_attn, w_bo_pool, w_out, ln1_g, ln1_b, w_mlp1, b_mlp1, w_mlp2, b_mlp2, ln2_g, ln2_b):
    layer_params = (w_in, sink, w_pool, pool_scale, w_bo_attn, w_bo_pool, w_out, ln1_g, ln1_b,
                    w_mlp1, b_mlp1, w_mlp2, b_mlp2, ln2_g, ln2_b)
    y_prompt = encode(x_prompt, meta_tokens, ln_emb_g, ln_emb_b, layer_params)
    y_sample = encode(x_sample, meta_tokens, ln_emb_g, ln_emb_b, layer_params)
    return (y_prompt, y_sample)
```

```cpp
#define STOP_AFTER 0


#include <hip/hip_runtime.h>
#include <hip/hip_cooperative_groups.h>
#include <cstdio>
#include <cstdint>
#include <cmath>
namespace cg = cooperative_groups;
namespace pg8 {
#define PG8_LAS __attribute__((address_space(3)))
typedef unsigned short bf16_t;
typedef short bf16x8 __attribute__((ext_vector_type(8)));
typedef float f32x4 __attribute__((ext_vector_type(4)));
typedef unsigned u32x4 __attribute__((ext_vector_type(4)));
constexpr int BM = 256, BK = 64, HALF = 128, HTB = HALF * BK * 2  , STAGE_BYTES = 8 * HTB, NXCD = 8, WGM = 8;

__host__ __device__ __forceinline__ int lds_byte(int r, int c) { const int st = (r >> 4) * 2 + (c >> 5), rr = r & 15, cc = c & 31, ob = rr * 64 + cc * 2; return st * 1024 + (ob ^ (((ob >> 9) & 1) << 5)); }
__host__ __device__ __forceinline__ void stage_rc(int b, int& R, int& C) { const int st = b / 1024, sb = b % 1024, swz = sb ^ (((sb >> 9) & 1) << 5); R = (st >> 1) * 16 + swz / 64; C = (st & 1) * 32 + (swz % 64) / 2; }
__host__ __device__ __forceinline__ int perm32(int rho) { const int n = rho >> 4, i = rho & 15; return 8 * (i >> 2) + 4 * n + (i & 3); }

struct Unit { int pm, pn; };
struct Gemm { const bf16_t* A; const bf16_t* Bt; int M, N, K; };

struct StaticOrder {
    int nM, nN, nwg, G, c;
    __host__ __device__ void init(int M, int N, int G_, int c_) { nM = M / BM; nN = N / BM; nwg = nM * nN; G = G_; c = c_; }
    __host__ __device__ bool next(int i, Unit& u) const {
        const long L = (long)i * G + c; if (L >= nwg) return false;
        int wgid = (int)L; { const int q = nwg / NXCD, r = nwg % NXCD, xcd = wgid % NXCD, off = wgid / NXCD; wgid = (xcd < r ? xcd * (q + 1) : r * (q + 1) + (xcd - r) * q) + off; }
        const int nig = WGM * nN, gid = wgid / nig, fm = gid * WGM, gsz = (nM - fm) < WGM ? (nM - fm) : WGM;
        u.pm = fm + ((wgid % nig) % gsz); u.pn = (wgid % nig) / gsz; return true;
    }
    __device__ __forceinline__ void a_ready(const Unit&) const {}
    __device__ __forceinline__ void done(const Unit&) const {}
};

typedef float f32x2_cv __attribute__((ext_vector_type(2))); typedef __bf16 bf16x2_cv __attribute__((ext_vector_type(2)));
__device__ __forceinline__ unsigned cvt_pk_bf16(float lo, float hi) { f32x2_cv v = {lo, hi}; bf16x2_cv b = __builtin_convertvector(v, bf16x2_cv); return __builtin_bit_cast(unsigned, b); }
typedef float f32x2 __attribute__((ext_vector_type(2)));
typedef unsigned u32x4 __attribute__((ext_vector_type(4)));
__device__ __forceinline__ float bf_lo(unsigned w) { return __builtin_bit_cast(float, w << 16); }
__device__ __forceinline__ float bf_hi(unsigned w) { return __builtin_bit_cast(float, w & 0xffff0000u); }
__device__ __forceinline__ u32x4 pack8(f32x4 a, f32x4 b) { u32x4 w; w.x = cvt_pk_bf16(a[0], a[1]); w.y = cvt_pk_bf16(a[2], a[3]); w.z = cvt_pk_bf16(b[0], b[1]); w.w = cvt_pk_bf16(b[2], b[3]); return w; }
__device__ __forceinline__ void unpack8(u32x4 w, f32x4& a, f32x4& b) { a = (f32x4){bf_lo(w.x), bf_hi(w.x), bf_lo(w.y), bf_hi(w.y)}; b = (f32x4){bf_lo(w.z), bf_hi(w.z), bf_lo(w.w), bf_hi(w.w)}; }
__device__ __forceinline__ float sigm(float x) { return __builtin_amdgcn_rcpf(1.0f + __builtin_amdgcn_exp2f(x * -1.4426950408889634f)); }

template <int MODE> struct EpiB {
    static constexpr bool PERM = true, AFTER_DRAIN = false;
    bf16_t* O; int ldc; const float* bias; const bf16_t* G; int ldg; int gcol0; float scale0; int scale_tiles;
    __device__ __forceinline__ void operator()(const f32x4 (&acc)[2][2][4][2], const Unit& u, int wr, int wc, int fr, int fq) const {
        const int row0 = u.pm * BM + wr * 64 + fr; const int col0 = u.pn * BM + wc * 32 + 8 * fq;
        const float sc = (MODE == 0 && u.pn < scale_tiles) ? scale0 : 1.0f;
        f32x4 bv[2][2];
        if (MODE == 2) {
#pragma unroll
            for (int bj = 0; bj < 2; ++bj)
#pragma unroll
                for (int n = 0; n < 2; ++n) bv[bj][n] = *(const f32x4*)(bias + col0 + bj * HALF + 4 * n);
        }
#pragma unroll
        for (int ai = 0; ai < 2; ++ai)
#pragma unroll
            for (int m = 0; m < 4; ++m) { const size_t row = (size_t)(row0 + ai * HALF + m * 16); bf16_t* rowp = O + row * ldc + col0;
#pragma unroll
                for (int bj = 0; bj < 2; ++bj) { f32x4 v0 = acc[ai][bj][m][0], v1 = acc[ai][bj][m][1];
                    if (MODE == 0) { v0 = v0 * sc; v1 = v1 * sc; }
                    if (MODE == 1) { v0 = (f32x4){sigm(v0[0]), sigm(v0[1]), sigm(v0[2]), sigm(v0[3])}; v1 = (f32x4){sigm(v1[0]), sigm(v1[1]), sigm(v1[2]), sigm(v1[3])}; }
                    if (MODE == 2) { v0 = v0 + bv[bj][0]; v1 = v1 + bv[bj][1]; v0 = __builtin_elementwise_max(v0, (f32x4){0.f, 0.f, 0.f, 0.f}); v1 = __builtin_elementwise_max(v1, (f32x4){0.f, 0.f, 0.f, 0.f}); v0 = v0 * v0; v1 = v1 * v1; }
                    if (MODE == 3 || MODE == 4) { const u32x4 gw = *(const u32x4*)(G + row * ldg + gcol0 + col0 + bj * HALF); f32x4 g0, g1; unpack8(gw, g0, g1); v0 = v0 * g0; v1 = v1 * g1; }
                    if (MODE == 4) { const u32x4 ow = *(const u32x4*)(rowp + bj * HALF); f32x4 o0, o1; unpack8(ow, o0, o1); v0 = v0 + o0; v1 = v1 + o1; }
                    *(u32x4*)(rowp + bj * HALF) = pack8(v0, v1); }
                if (MODE >= 3) asm volatile("" ::: "memory"); }
    }
};
struct EpiRes {
    static constexpr bool PERM = false, AFTER_DRAIN = false;
    float* X; float* X2; int split_row; int ldc; const float* bias; float alpha;
    __device__ __forceinline__ void operator()(const f32x4 (&acc)[2][2][4][2], const Unit& u, int wr, int wc, int fr, int fq) const {
        const int col0 = u.pn * BM + wc * 32 + 4 * fq;
        float* base = (u.pm * BM >= split_row) ? X2 + (size_t)(u.pm * BM - split_row) * ldc : X + (size_t)(u.pm * BM) * ldc;
        f32x4 bv[2][2];
#pragma unroll
        for (int bj = 0; bj < 2; ++bj)
#pragma unroll
            for (int n = 0; n < 2; ++n) bv[bj][n] = bias ? *(const f32x4*)(bias + col0 + bj * HALF + n * 16) : (f32x4){0.f, 0.f, 0.f, 0.f};
#pragma unroll
        for (int ai = 0; ai < 2; ++ai)
#pragma unroll
            for (int m = 0; m < 4; ++m) { float* rowp = base + (size_t)(ai * HALF + wr * 64 + m * 16 + fr) * ldc + col0;
#pragma unroll
                for (int bj = 0; bj < 2; ++bj)
#pragma unroll
                    for (int n = 0; n < 2; ++n) { f32x4* p = (f32x4*)(rowp + bj * HALF + n * 16); const f32x4 x = *p; *p = x * alpha + (acc[ai][bj][m][n] + bv[bj][n]); }
                asm volatile("" ::: "memory"); }
    }
};

template <class Epi, class Sched, bool ALIGN_EPI = false, bool SP2 = false>
__device__ __forceinline__ void gemm_phase(PG8_LAS unsigned char* lds, const Gemm g, const Sched& S, const Epi& E) {
    int tid_ = threadIdx.x; asm volatile("" : "+v"(tid_));
    const int tid = tid_, wid = __builtin_amdgcn_readfirstlane(tid >> 6), lane = tid & 63, wr = wid >> 2, wc = wid & 3, fr = lane & 15, fq = lane >> 4;
    const int K = g.K, nt = K / BK;
    unsigned voffA[2], voffB[2];
#pragma unroll
    for (int i = 0; i < 2; ++i) { int R, C; stage_rc(tid * 16 + i * 8192, R, C); const int Rb = Epi::PERM ? ((R & ~31) + perm32(R & 31)) : R;
        voffA[i] = (unsigned)(R * K + C) * 2u; voffB[i] = (unsigned)(Rb * K + C) * 2u; }
    const size_t kstep = (size_t)(BK * 2);
    const size_t hstep = (size_t)HALF * K * 2;
    const size_t tstep = 2 * hstep;
    const unsigned ldsw = (unsigned)wid * 1024u;
    const int aoff = lds_byte(wr * 64 + fr, fq * 8), boff = lds_byte(wc * 32 + fr, fq * 8);
#define PG8_SA(b, h) (((b) * 2 + (h)) * HTB)
#define PG8_SB(b, h) ((4 + (b) * 2 + (h)) * HTB)
#define PG8_STAGE(bufoff, gbase, voff) do { _Pragma("unroll") for (int _i = 0; _i < 2; ++_i) \
        __builtin_amdgcn_global_load_lds((const unsigned*)((const char*)(gbase) + (voff)[_i]), (PG8_LAS unsigned*)(lds + (bufoff) + ldsw + _i * 8192), 16, 0, 0); } while (0)
#define PG8_LDA(dst, b, h) do { _Pragma("unroll") for (int m = 0; m < 4; ++m) _Pragma("unroll") for (int k = 0; k < 2; ++k) dst[m][k] = *(const PG8_LAS bf16x8*)(lds + PG8_SA(b, h) + aoff + m * 2048 + k * 1024); } while (0)
#define PG8_LDB(dst, b, h) do { _Pragma("unroll") for (int n = 0; n < 2; ++n) _Pragma("unroll") for (int k = 0; k < 2; ++k) dst[n][k] = *(const PG8_LAS bf16x8*)(lds + PG8_SB(b, h) + boff + n * 2048 + k * 1024); } while (0)
#define PG8_MMA(ai, bj, At, Bt) do { __builtin_amdgcn_s_setprio(1); _Pragma("unroll") for (int m = 0; m < 4; ++m) _Pragma("unroll") for (int n = 0; n < 2; ++n) _Pragma("unroll") for (int k = 0; k < 2; ++k) \
        acc[ai][bj][m][n] = __builtin_amdgcn_mfma_f32_16x16x32_bf16(Bt[n][k], At[m][k], acc[ai][bj][m][n], 0, 0, 0); __builtin_amdgcn_s_setprio(0); } while (0)
#define PG8_WAIT_V(n) asm volatile("s_waitcnt vmcnt(" #n ")" ::: "memory")
#define PG8_WAIT_L(n) asm volatile("s_waitcnt lgkmcnt(" #n ")" ::: "memory")
#define PG8_BAR __builtin_amdgcn_s_barrier()
#define PG8_SCHED __builtin_amdgcn_sched_barrier(0)
    Unit cur, nxt; int ui = 0;
    if (!S.next(0, cur)) return;
    f32x4 acc[2][2][4][2];
#pragma unroll
    for (int a = 0; a < 2; ++a)
#pragma unroll
        for (int b = 0; b < 2; ++b)
#pragma unroll
            for (int m = 0; m < 4; ++m)
#pragma unroll
                for (int n = 0; n < 2; ++n) acc[a][b][m][n] = (f32x4){0.f, 0.f, 0.f, 0.f};
    bf16x8 At[4][2], B0[2][2], B1[2][2];
    const char* cA = (const char*)g.A + (size_t)cur.pm * tstep; const char* cB = (const char*)g.Bt + (size_t)cur.pn * tstep;
    S.a_ready(cur);
    if constexpr (SP2) {
        PG8_STAGE(PG8_SB(0, 0), cB, voffB); PG8_STAGE(PG8_SB(0, 1), cB + hstep, voffB); PG8_STAGE(PG8_SA(0, 0), cA, voffA); PG8_STAGE(PG8_SA(0, 1), cA + hstep, voffA);
        if (wr == 1) PG8_BAR;
        PG8_WAIT_V(2); PG8_BAR;
        PG8_STAGE(PG8_SB(1, 0), cB + kstep, voffB); PG8_STAGE(PG8_SA(1, 0), cA + kstep, voffA); PG8_STAGE(PG8_SB(1, 1), cB + hstep + kstep, voffB);
        PG8_WAIT_V(6); PG8_BAR;
    } else {
        PG8_STAGE(PG8_SB(0, 0), cB, voffB); PG8_STAGE(PG8_SA(0, 0), cA, voffA); PG8_STAGE(PG8_SB(0, 1), cB + hstep, voffB); PG8_STAGE(PG8_SA(0, 1), cA + hstep, voffA);
        if (wr == 1) PG8_BAR;
        PG8_WAIT_V(4); PG8_BAR;
        PG8_STAGE(PG8_SB(1, 0), cB + kstep, voffB); PG8_STAGE(PG8_SA(1, 0), cA + kstep, voffA); PG8_STAGE(PG8_SB(1, 1), cB + hstep + kstep, voffB);
        PG8_WAIT_V(6); PG8_BAR;
    }
    for (;;) {
        const bool has_next = S.next(ui + 1, nxt);
        const char* nA = has_next ? (const char*)g.A + (size_t)nxt.pm * tstep : cA; const char* nB = has_next ? (const char*)g.Bt + (size_t)nxt.pn * tstep : cB;
        for (int t = 0; t < nt; t += 2) {
            const bool last = (t == nt - 2);
            const char* a1 = cA + (size_t)(t + 1) * kstep;
            const char* a2 = last ? nA : cA + (size_t)(t + 2) * kstep; const char* b2 = last ? nB : cB + (size_t)(t + 2) * kstep;
            const char* a3 = a2 + kstep; const char* b3 = b2 + kstep;
            if (last && has_next) S.a_ready(nxt);
            if constexpr (SP2) {
            PG8_LDB(B0, 0, 0); PG8_LDB(B1, 0, 1); PG8_SCHED; PG8_LDA(At, 0, 0); PG8_STAGE(PG8_SA(1, 1), a1 + hstep, voffA);
            PG8_WAIT_V(8); PG8_WAIT_L(0); PG8_BAR; PG8_MMA(0, 0, At, B0); PG8_MMA(0, 1, At, B1); PG8_BAR; PG8_SCHED;
            PG8_LDA(At, 0, 1); PG8_STAGE(PG8_SB(0, 0), b2, voffB); PG8_STAGE(PG8_SB(0, 1), b2 + hstep, voffB); PG8_STAGE(PG8_SA(0, 0), a2, voffA);
            PG8_WAIT_V(8); PG8_WAIT_L(0); PG8_BAR; PG8_MMA(1, 0, At, B0); PG8_MMA(1, 1, At, B1); PG8_BAR; PG8_SCHED;
            PG8_LDB(B0, 1, 0); PG8_LDB(B1, 1, 1); PG8_SCHED; PG8_LDA(At, 1, 0); PG8_STAGE(PG8_SA(0, 1), a2 + hstep, voffA);
            PG8_WAIT_V(8); PG8_WAIT_L(0); PG8_BAR; PG8_MMA(0, 0, At, B0); PG8_MMA(0, 1, At, B1); PG8_BAR; PG8_SCHED;
            PG8_LDA(At, 1, 1); PG8_STAGE(PG8_SB(1, 0), b3, voffB); PG8_STAGE(PG8_SB(1, 1), b3 + hstep, voffB); PG8_STAGE(PG8_SA(1, 0), a3, voffA);
            PG8_WAIT_V(8); PG8_WAIT_L(0); PG8_BAR; PG8_MMA(1, 0, At, B0); PG8_MMA(1, 1, At, B1); PG8_BAR; PG8_SCHED;
            } else {
            PG8_LDB(B0, 0, 0); PG8_SCHED; PG8_LDA(At, 0, 0); PG8_STAGE(PG8_SA(1, 1), a1 + hstep, voffA);
            PG8_WAIT_L(8); PG8_BAR; PG8_WAIT_L(0); PG8_MMA(0, 0, At, B0); PG8_BAR; PG8_SCHED;
            PG8_LDB(B1, 0, 1); PG8_STAGE(PG8_SB(0, 0), b2, voffB);
            PG8_BAR; PG8_WAIT_L(0); PG8_MMA(0, 1, At, B1); PG8_BAR;
            PG8_LDA(At, 0, 1); PG8_STAGE(PG8_SA(0, 0), a2, voffA);
            PG8_BAR; PG8_WAIT_L(0); PG8_MMA(1, 0, At, B0); PG8_BAR; PG8_SCHED;
            PG8_STAGE(PG8_SB(0, 1), b2 + hstep, voffB);
            PG8_WAIT_V(6); PG8_BAR; PG8_MMA(1, 1, At, B1); PG8_BAR;
            PG8_LDB(B0, 1, 0); PG8_SCHED; PG8_LDA(At, 1, 0); PG8_STAGE(PG8_SA(0, 1), a2 + hstep, voffA);
            PG8_WAIT_L(8); PG8_BAR; PG8_WAIT_L(0); PG8_MMA(0, 0, At, B0); PG8_BAR; PG8_SCHED;
            PG8_LDB(B1, 1, 1); PG8_STAGE(PG8_SB(1, 0), b3, voffB);
            PG8_BAR; PG8_WAIT_L(0); PG8_MMA(0, 1, At, B1); PG8_BAR;
            PG8_LDA(At, 1, 1); PG8_STAGE(PG8_SA(1, 0), a3, voffA);
            PG8_BAR; PG8_WAIT_L(0); PG8_MMA(1, 0, At, B0); PG8_BAR; PG8_SCHED;
            PG8_STAGE(PG8_SB(1, 1), b3 + hstep, voffB);
            PG8_WAIT_V(6); PG8_BAR; PG8_MMA(1, 1, At, B1); PG8_BAR;
            }
        }
        if constexpr (ALIGN_EPI) { if (wr == 0) PG8_BAR; }
        if constexpr (!Epi::AFTER_DRAIN) { E(acc, cur, wr, wc, fr, fq); S.done(cur); }
        if (!has_next) break;
#pragma unroll
        for (int a = 0; a < 2; ++a)
#pragma unroll
            for (int b = 0; b < 2; ++b)
#pragma unroll
                for (int m = 0; m < 4; ++m)
#pragma unroll
                    for (int n = 0; n < 2; ++n) acc[a][b][m][n] = (f32x4){0.f, 0.f, 0.f, 0.f};
        cur = nxt; cA = nA; cB = nB; ++ui;
        if constexpr (ALIGN_EPI) { if (wr == 1) PG8_BAR; }
    }
    PG8_WAIT_V(0);
    if constexpr (!ALIGN_EPI) { if (wr == 0) PG8_BAR; }
    PG8_BAR;
    if constexpr (Epi::AFTER_DRAIN) { E.fused(acc, cur, wr, wc, fr, fq, lds, wid, lane); S.done(cur); }
#undef PG8_SA
#undef PG8_SB
#undef PG8_STAGE
#undef PG8_LDA
#undef PG8_LDB
#undef PG8_MMA
#undef PG8_WAIT_V
#undef PG8_WAIT_L
#undef PG8_BAR
#undef PG8_SCHED
}
}
#define GAS __attribute__((address_space(1)))
#define LAS __attribute__((address_space(3)))
typedef unsigned short bf16;
typedef unsigned v4u __attribute__((ext_vector_type(4)));
typedef float f32x4 __attribute__((ext_vector_type(4)));
typedef short bf16x8 __attribute__((ext_vector_type(8)));
typedef GAS unsigned gu32;
typedef GAS unsigned long long gu64;
#define RLX_AGENT __ATOMIC_RELAXED, __HIP_MEMORY_SCOPE_AGENT
#define LDS_WAIT() asm volatile("s_waitcnt lgkmcnt(0)" ::: "memory")
#define VM_WAIT() asm volatile("s_waitcnt vmcnt(0)" ::: "memory")
__device__ __forceinline__ unsigned long long rt() { return __builtin_amdgcn_s_memrealtime(); }
__device__ __forceinline__ unsigned f2bf(float f) { unsigned u = __builtin_bit_cast(unsigned, f); return (u + 0x7fffu + ((u >> 16) & 1u)) >> 16; }
__device__ __forceinline__ unsigned pk2(float lo, float hi) { return f2bf(lo) | (f2bf(hi) << 16); }

#define XB_TMO      128
#define XB_XCNT(j)  (256  + 64 * (j))
#define XB_XSUB(j)  (1280 + 64 * (j))
#define XB_XGEN(j)  (2304 + 64 * (j))
#define XB_TOP      3328
#define XB_TOPGEN   3392
#define XCD_BAR_WORDS 3456
#define XB_SPIN_CAP (1u << 18)

__device__ __forceinline__ unsigned xb_ld(unsigned* p)              { return __hip_atomic_load(p, __ATOMIC_RELAXED, __HIP_MEMORY_SCOPE_AGENT); }
__device__ __forceinline__ unsigned xb_add(unsigned* p, unsigned v) { return __hip_atomic_fetch_add(p, v, __ATOMIC_RELAXED, __HIP_MEMORY_SCOPE_AGENT); }
__device__ __forceinline__ unsigned xb_xcc_id() { return (unsigned)__builtin_amdgcn_s_getreg((3 << 11) | 20) & 0xFu; }
#define XB_SPIN(cond, bar) do { unsigned _sp = 0; while (cond) { __builtin_amdgcn_s_sleep(1); \
    if ((++_sp & 255u) == 0u) { if (xb_ld(&(bar)[XB_TMO])) break; if (_sp > XB_SPIN_CAP) { atomicAdd(&(bar)[XB_TMO], 1u); break; } } } } while (0)

struct XcdBarrier {
    unsigned* bar; unsigned x;
    volatile LAS unsigned* st;
};

__device__ __forceinline__ XcdBarrier xcd_barrier_post(unsigned* bar, volatile LAS unsigned* st) {
    XcdBarrier b; b.bar = bar; b.x = xb_xcc_id(); b.st = st;
    if (threadIdx.x == 0) (void)xb_add(&bar[XB_XCNT(b.x)], 1u);
    return b;
}
__device__ __forceinline__ void xcd_barrier_complete(unsigned* bar, unsigned x, unsigned& nloc, unsigned& nx) {
    const unsigned G = gridDim.x * gridDim.y * gridDim.z;
    unsigned sum, cnt, mine, sp = 0u;
    for (;;) {
        sum = 0u; cnt = 0u; mine = 0u;
#pragma unroll
        for (unsigned j = 0; j < 16; ++j) { const unsigned c = xb_ld(&bar[XB_XCNT(j)]); sum += c; cnt += (c > 0u) ? 1u : 0u; mine = (j == x) ? c : mine; }
        if (sum == G) break;
        __builtin_amdgcn_s_sleep(1);
        if ((++sp & 255u) == 0u) { if (xb_ld(&bar[XB_TMO])) break; if (sp > XB_SPIN_CAP) { atomicAdd(&bar[XB_TMO], 1u); break; } }
    }
    nloc = mine > 0u ? mine : 1u; nx = cnt > 0u ? cnt : 1u;
}

__device__ __forceinline__ void xcd_barrier(const XcdBarrier& b) {
    asm volatile("s_waitcnt vmcnt(0)" ::: "memory");
    __syncthreads();
    if (threadIdx.x == 0) {
        unsigned* bar = b.bar;
        __builtin_amdgcn_s_waitcnt(0);
        unsigned nloc = b.st[0], nx = b.st[1];
        if (nloc == 0u) { xcd_barrier_complete(bar, b.x, nloc, nx); b.st[0] = nloc; b.st[1] = nx; }
        const unsigned old = xb_add(&bar[XB_XSUB(b.x)], 1u);
        const unsigned gen = old / nloc;
        if (old + 1u == (gen + 1u) * nloc) {
            __builtin_amdgcn_fence(__ATOMIC_RELEASE, "agent");
            asm volatile("s_waitcnt vmcnt(0)" ::: "memory");
            const unsigned og = xb_add(&bar[XB_TOP], 1u);
            const unsigned tg = og / nx;
            if (og + 1u == (tg + 1u) * nx) xb_add(&bar[XB_TOPGEN], 1u);
            else XB_SPIN(xb_ld(&bar[XB_TOPGEN]) == tg, bar);
            __builtin_amdgcn_fence(__ATOMIC_ACQUIRE, "agent");
            xb_add(&bar[XB_XGEN(b.x)], 1u);
            asm volatile("s_waitcnt vmcnt(0)" ::: "memory");
        } else {
            XB_SPIN(xb_ld(&bar[XB_XGEN(b.x)]) == gen, bar);
            __builtin_amdgcn_fence(__ATOMIC_ACQUIRE, "agent");
            asm volatile("s_waitcnt vmcnt(0)" ::: "memory");
        }
    }
    __syncthreads();
}

constexpr int D = 1024, DEPTH = 4, NSEQ = 6, NMETA = 16, DFF = 4096, INW = 4096;
constexpr int MREAL = 32768, MROWS = MREAL + NSEQ * NMETA  , MP = 33024  ;
constexpr float LN_EPS = 1e-5f;
constexpr float ALPHA = 1.6817928305074290f;
constexpr float LOG2E = 1.4426950408889634f;
constexpr float QSCALE = 0.125f * LOG2E;
constexpr int PJ = 2048, PJ_K = 1024, PJ_V = 1280, PJ_U = 1536;

constexpr size_t MiB = 1u << 20;
constexpr size_t WS_CTL = 0;
constexpr size_t WS_WIN = 1 * MiB, WS_WA = 9 * MiB, WS_WP = 11 * MiB, WS_WOUT = 12 * MiB, WS_W1 = 14 * MiB, WS_W2 = 22 * MiB;
constexpr size_t WS_XFM = 30 * MiB;
constexpr size_t WS_XB = 31 * MiB;
constexpr size_t SZ_XB = (size_t)MP * 1024 * 2;
constexpr size_t WS_A = WS_XB + SZ_XB;
constexpr size_t SZ_A = (size_t)MP * 2048 * 2;
constexpr size_t WS_B = WS_A + SZ_A;
constexpr size_t WS_END = WS_B + SZ_A;
constexpr int LDS_BYTES = 147456;

struct Args {
    const float *xp, *xs, *meta, *lneg, *lneb, *win, *sink, *wpool, *pscale, *wba, *wbp, *wout, *ln1g, *ln1b, *w1, *b1, *w2, *b2, *ln2g, *ln2b;
    float* out; unsigned char* ws;
};

__device__ __forceinline__ float wave_sum(float v) {
#pragma unroll
    for (int o = 1; o < 64; o <<= 1) v += __shfl_xor(v, o);
    return v;
}
__device__ __forceinline__ unsigned cvtpk(float lo, float hi) { return pg8::cvt_pk_bf16(lo, hi); }

__device__ __forceinline__ void transpose_item(const float* __restrict__ W, int K, int N, bf16* __restrict__ WT, LAS float* scr, int item, int lane) {
    const int nblk = N / 32, kb = item / nblk, nb = item % nblk, k0 = 64 * kb, n0 = 32 * nb;
#pragma unroll 8
    for (int i = 0; i < 32; ++i) { const int kk = 2 * i + (lane >> 5); scr[kk * 33 + (lane & 31)] = W[(size_t)(k0 + kk) * N + n0 + (lane & 31)]; }
    LDS_WAIT(); asm volatile("" ::: "memory");
    const int c = lane & 7;
#pragma unroll
    for (int j = 0; j < 4; ++j) { const int n = (lane >> 3) + 8 * j; const LAS float* s = scr + (8 * c) * 33 + n;
        v4u o; o.x = cvtpk(s[0 * 33], s[1 * 33]); o.y = cvtpk(s[2 * 33], s[3 * 33]); o.z = cvtpk(s[4 * 33], s[5 * 33]); o.w = cvtpk(s[6 * 33], s[7 * 33]);
        *(v4u*)(WT + (size_t)(n0 + n) * K + k0 + 8 * c) = o; }
    LDS_WAIT(); asm volatile("" ::: "memory");
}

__device__ __forceinline__ void convert_weights(const Args& a, int l, LAS unsigned char* lds, int gw, int NGW, int wave, int lane) {
    unsigned char* ws = a.ws;
    LAS float* scr = (LAS float*)(lds + wave * 16384);
    constexpr int I_IN = (D / 64) * (INW / 32), I_SQ = (D / 64) * (D / 32), I_1 = (D / 64) * (DFF / 32), I_2 = (DFF / 64) * (D / 32);
    constexpr int NIT = I_IN + 2 * I_SQ + I_1 + I_2;
    for (int it = gw; it < NIT; it += NGW) {
        int r = it;
        if (r < I_IN) { transpose_item(a.win + (size_t)l * D * INW, D, INW, (bf16*)(ws + WS_WIN), scr, r, lane); continue; } r -= I_IN;
        if (r < I_SQ) { transpose_item(a.wba + (size_t)l * D * D, D, D, (bf16*)(ws + WS_WA), scr, r, lane); continue; } r -= I_SQ;
        if (r < I_SQ) { transpose_item(a.wout + (size_t)l * D * D, D, D, (bf16*)(ws + WS_WOUT), scr, r, lane); continue; } r -= I_SQ;
        if (r < I_1) { transpose_item(a.w1 + (size_t)l * D * DFF, D, DFF, (bf16*)(ws + WS_W1), scr, r, lane); continue; } r -= I_1;
        transpose_item(a.w2 + (size_t)l * DFF * D, DFF, D, (bf16*)(ws + WS_W2), scr, r, lane);
    }
    const float* wpool = a.wpool + (size_t)l * 4 * 128 * 128; const float* ps = a.pscale + (size_t)l * 512; const float* wbp = a.wbp + (size_t)l * 512 * D;
    bf16* WPT = (bf16*)(ws + WS_WP);
    for (int it = gw; it < 1024; it += NGW) {
        const int cch = it >> 4, n = ((it & 15) << 6) + lane; const int g = cch >> 4, c0 = (cch & 15) * 8;
        float acc[8];
#pragma unroll
        for (int e = 0; e < 8; ++e) acc[e] = 0.f;
        const float* wp = wpool + (size_t)(g * 128 + c0) * 128;
        for (int j = 0; j < 128; ++j) {
            const float w = ps[g * 128 + j] * wbp[(size_t)(g * 128 + j) * D + n];
#pragma unroll
            for (int e = 0; e < 8; ++e) acc[e] += wp[e * 128 + j] * w;
        }
        v4u o; o.x = cvtpk(acc[0], acc[1]); o.y = cvtpk(acc[2], acc[3]); o.z = cvtpk(acc[4], acc[5]); o.w = cvtpk(acc[6], acc[7]);
        *(v4u*)(WPT + (size_t)n * 512 + g * 128 + c0) = o;
    }
}

__device__ __forceinline__ void ln_row(const float* src, float* dstF, bf16* dstB, const float* __restrict__ g, const float* __restrict__ b, int lane) {
    const f32x4* xr = (const f32x4*)src + lane;
    f32x4 v[4]; float s = 0.f;
#pragma unroll
    for (int j = 0; j < 4; ++j) { v[j] = xr[64 * j]; s += (v[j].x + v[j].y) + (v[j].z + v[j].w); }
    const float mean = wave_sum(s) * (1.f / D); float s2 = 0.f;
#pragma unroll
    for (int j = 0; j < 4; ++j) { v[j] = v[j] - mean; s2 += (v[j].x * v[j].x + v[j].y * v[j].y) + (v[j].z * v[j].z + v[j].w * v[j].w); }
    const float rstd = 1.f / sqrtf(wave_sum(s2) * (1.f / D) + LN_EPS);
#pragma unroll
    for (int j = 0; j < 4; ++j) {
        const f32x4 gg = ((const f32x4*)g)[lane + 64 * j], bb = ((const f32x4*)b)[lane + 64 * j];
        const f32x4 y = v[j] * rstd * gg + bb;
        if (dstF) ((f32x4*)dstF)[lane + 64 * j] = y;
        typedef unsigned u32x2v __attribute__((ext_vector_type(2)));
        u32x2v w; w.x = cvtpk(y.x, y.y); w.y = cvtpk(y.z, y.w);
        ((u32x2v*)dstB)[lane + 64 * j] = w;
    }
}

typedef float f32x16 __attribute__((ext_vector_type(16)));
typedef short s16x4 __attribute__((ext_vector_type(4)));
constexpr int AT_KROWS = 416, AT_ROWB = 128, AT_LDS_V = AT_KROWS * AT_ROWB;
__device__ __forceinline__ int at_koff(int row, int c) { return row * AT_ROWB + ((c ^ ((row >> 1) & 7)) << 4); }
__device__ __forceinline__ int at_voff(int row, int c) { return row * AT_ROWB + ((c ^ (((row >> 1) & 1) << 2)) << 4); }
__device__ __forceinline__ float half_max(float m) { auto rr = __builtin_amdgcn_permlane32_swap(__float_as_uint(m), __float_as_uint(m), false, false); return __builtin_fmaxf(__uint_as_float(rr[0]), __uint_as_float(rr[1])); }
__device__ __forceinline__ float half_sum(float m) { auto rr = __builtin_amdgcn_permlane32_swap(__float_as_uint(m), __float_as_uint(m), false, false); return __uint_as_float(rr[0]) + __uint_as_float(rr[1]); }
__device__ __forceinline__ s16x4 vtr(const LAS unsigned char* p) { typedef short v4i16_t __attribute__((ext_vector_type(4))); return __builtin_bit_cast(s16x4, __builtin_amdgcn_ds_read_tr16_b64_v4i16((LAS v4i16_t*)p)); }

__device__ __forceinline__ void attn_unit(LAS unsigned char* lds, const bf16* __restrict__ PROJ, bf16* __restrict__ AO, bf16* __restrict__ DB, const float* __restrict__ sink_l, int s, int n, int kh) {
    const int tid = threadIdx.x, lane = tid & 63, l31 = lane & 31, hi = lane >> 5;
    const int wid = __builtin_amdgcn_readfirstlane(tid >> 6);
    const int S = s < 2 ? 8192 : 4096, rb = s < 2 ? s * 8192 : 16384 + (s - 2) * 4096, mb = MREAL + 16 * s, L = S + 16;
    {
        const int half = 1 << kh, nit = (n >= 0) ? 128 * 16 : 16 * 16, p0 = (n >= 0) ? 16 + 128 * n : 0;
        for (int it = tid; it < nit; it += 512) {
            const int p = p0 + (it >> 4), c = it & 15;
            const bf16* ucol = PROJ + PJ_U + 128 * kh + 8 * c;
            const int lo = p - half < 0 ? 0 : p - half, hi_ = p + half > L ? L : p + half;
            f32x4 a0 = {0.f, 0.f, 0.f, 0.f}, a1 = {0.f, 0.f, 0.f, 0.f};
            for (int pos = lo; pos < hi_; ++pos) { const int row = pos < 16 ? mb + pos : rb + pos - 16; const v4u w = *(const v4u*)(ucol + (size_t)row * PJ); f32x4 x0, x1; pg8::unpack8(w, x0, x1); a0 += x0; a1 += x1; }
            const int prow = p < 16 ? mb + p : rb + p - 16;
            const v4u cw = *(const v4u*)(ucol + (size_t)prow * PJ); f32x4 c0, c1; pg8::unpack8(cw, c0, c1);
            const float inv = 1.0f / (float)(hi_ - lo);
            a0 = a0 * inv - c0; a1 = a1 * inv - c1;
            *(v4u*)(DB + (size_t)prow * 512 + 128 * kh + 8 * c) = pg8::pack8(a0, a1);
        }
    }
    const int band_start = (n >= 0) ? 128 * (n - 1) : 0, band_len = (n >= 0) ? 384 : 128;
    for (int idx = tid; idx < (16 + band_len) * 8; idx += 512) {
        const int r = idx >> 3, c = idx & 7; int lr, grow;
        if (r < 16) { lr = r; grow = mb + r; }
        else { const int key = band_start + (r - 16); lr = 32 + (r - 16); if (key < 0 || key >= S) continue; grow = rb + key; }
        const bf16* src = PROJ + (size_t)grow * PJ + PJ_K + kh * 64 + c * 8;
        const v4u kv = *(const v4u*)src; const v4u vv = *(const v4u*)(src + (PJ_V - PJ_K));
        *(LAS v4u*)(lds + at_koff(lr, c)) = kv;
        *(LAS v4u*)(lds + AT_LDS_V + at_voff(lr, c)) = vv;
    }
    __syncthreads();
    const int g = (n >= 0) ? (wid >> 1) : (wid & 3);
    const int nsb = (n >= 0) ? 2 : (wid < 4 ? 1 : 0);
    const int h = kh * 4 + g;
    const float nsl = -__builtin_amdgcn_exp2f(-0.5f * (float)(h + 1)) * LOG2E;
    const float sinkl = sink_l[h] * LOG2E;
    const int L15 = lane & 15, g4 = (lane >> 4) & 1;
    for (int sb = 0; sb < nsb; ++sb) {
        const int q0 = (n >= 0) ? 128 * n + 64 * (wid & 1) + 32 * sb : -16;
        const int qpos = q0 + l31;
        const int qrow = qpos >= 0 ? rb + qpos : mb + 16 + qpos;
        const bool qvalid = (n >= 0) || (l31 < 16);
        bf16x8 qf[4];
#pragma unroll
        for (int d0 = 0; d0 < 4; ++d0) qf[d0] = *(const bf16x8*)(PROJ + (size_t)qrow * PJ + h * 64 + d0 * 16 + hi * 8);
        float m = sinkl, lsum = (hi == 0) ? 1.0f : 0.0f;
        f32x16 o0 = {}, o1 = {};
        const int vr = 4 * hi + (L15 >> 2), vc = 2 * g4 + ((L15 & 3) >> 1), vb = (L15 & 1) * 8;
        {
            f32x16 p = {};
#pragma unroll
            for (int d0 = 0; d0 < 4; ++d0) { const bf16x8 kf = *(const LAS bf16x8*)(lds + at_koff(l31, 2 * d0 + hi)); p = __builtin_amdgcn_mfma_f32_32x32x16_bf16(kf, qf[d0], p, 0, 0, 0); }
            float mx = p[0];
#pragma unroll
            for (int r = 1; r < 8; ++r) mx = __builtin_fmaxf(mx, p[r]);
            mx = half_max(mx);
            const float mn = __builtin_fmaxf(m, mx), al = __builtin_amdgcn_exp2f(m - mn); m = mn;
            float sum = 0.f;
#pragma unroll
            for (int r = 0; r < 8; ++r) { p[r] = __builtin_amdgcn_exp2f(p[r] - mn); sum += p[r]; }
            lsum = lsum * al + sum;
            v4u pw; pw.x = cvtpk(p[0], p[1]); pw.y = cvtpk(p[2], p[3]); pw.z = cvtpk(p[4], p[5]); pw.w = cvtpk(p[6], p[7]);
            const bf16x8 pf = __builtin_bit_cast(bf16x8, pw);
#pragma unroll
            for (int dt = 0; dt < 2; ++dt) {
                const s16x4 lo = vtr(lds + AT_LDS_V + at_voff(vr, 4 * dt + vc) + vb), hh = vtr(lds + AT_LDS_V + at_voff(vr + 8, 4 * dt + vc) + vb);
                const bf16x8 vf = (bf16x8){lo[0], lo[1], lo[2], lo[3], hh[0], hh[1], hh[2], hh[3]};
                if (dt == 0) o0 = __builtin_amdgcn_mfma_f32_32x32x16_bf16(vf, pf, o0, 0, 0, 0); else o1 = __builtin_amdgcn_mfma_f32_32x32x16_bf16(vf, pf, o1, 0, 0, 0);
            }
        }
        int klo = q0 - 128; if (klo < band_start) klo = band_start; if (klo < 0) klo = 0;
        int khi = q0 + 160; if (khi > band_start + band_len) khi = band_start + band_len; if (khi > S) khi = S;
        for (int k0 = klo; k0 < khi; k0 += 32) {
            const int lr0 = 32 + (k0 - band_start);
            f32x16 p = {};
#pragma unroll
            for (int d0 = 0; d0 < 4; ++d0) { const bf16x8 kf = *(const LAS bf16x8*)(lds + at_koff(lr0 + l31, 2 * d0 + hi)); p = __builtin_amdgcn_mfma_f32_32x32x16_bf16(kf, qf[d0], p, 0, 0, 0); }
            const float basef = (float)(k0 - qpos + 4 * hi);
            const bool need_mask = (k0 + 31 - q0 > 128) || (q0 + 31 - k0 > 128);
#pragma unroll
            for (int r = 0; r < 16; ++r) { const float t = basef + (float)((r & 3) + 8 * (r >> 2)); float sc = p[r] + nsl * __builtin_fabsf(t); if (need_mask && __builtin_fabsf(t) > 128.0f) sc = -INFINITY; p[r] = sc; }
            float mx = p[0];
#pragma unroll
            for (int r = 1; r < 16; ++r) mx = __builtin_fmaxf(mx, p[r]);
            mx = half_max(mx);
            const float mn = __builtin_fmaxf(m, mx), al = __builtin_amdgcn_exp2f(m - mn); m = mn;
            float sum = 0.f;
#pragma unroll
            for (int r = 0; r < 16; ++r) { p[r] = __builtin_amdgcn_exp2f(p[r] - mn); sum += p[r]; }
            lsum = lsum * al + sum;
#pragma unroll
            for (int r = 0; r < 16; ++r) { o0[r] *= al; o1[r] *= al; }
#pragma unroll
            for (int st = 0; st < 2; ++st) {
                v4u pw; pw.x = cvtpk(p[8 * st + 0], p[8 * st + 1]); pw.y = cvtpk(p[8 * st + 2], p[8 * st + 3]); pw.z = cvtpk(p[8 * st + 4], p[8 * st + 5]); pw.w = cvtpk(p[8 * st + 6], p[8 * st + 7]);
                const bf16x8 pf = __builtin_bit_cast(bf16x8, pw);
                const int row = lr0 + 16 * st + vr;
#pragma unroll
                for (int dt = 0; dt < 2; ++dt) {
                    const s16x4 lo = vtr(lds + AT_LDS_V + at_voff(row, 4 * dt + vc) + vb), hh = vtr(lds + AT_LDS_V + at_voff(row + 8, 4 * dt + vc) + vb);
                    const bf16x8 vf = (bf16x8){lo[0], lo[1], lo[2], lo[3], hh[0], hh[1], hh[2], hh[3]};
                    if (dt == 0) o0 = __builtin_amdgcn_mfma_f32_32x32x16_bf16(vf, pf, o0, 0, 0, 0); else o1 = __builtin_amdgcn_mfma_f32_32x32x16_bf16(vf, pf, o1, 0, 0, 0);
                }
            }
        }
        const float inv = 1.0f / half_sum(lsum);
        if (qvalid) {
            bf16* orow = AO + (size_t)qrow * D + h * 64 + 4 * hi;
            typedef unsigned u32x2v __attribute__((ext_vector_type(2)));
#pragma unroll
            for (int a4 = 0; a4 < 4; ++a4) {
                u32x2v w0; w0.x = cvtpk(o0[4 * a4] * inv, o0[4 * a4 + 1] * inv); w0.y = cvtpk(o0[4 * a4 + 2] * inv, o0[4 * a4 + 3] * inv);
                u32x2v w1; w1.x = cvtpk(o1[4 * a4] * inv, o1[4 * a4 + 1] * inv); w1.y = cvtpk(o1[4 * a4 + 2] * inv, o1[4 * a4 + 3] * inv);
                *(u32x2v*)(orow + 8 * a4) = w0; *(u32x2v*)(orow + 32 + 8 * a4) = w1;
            }
        }
    }
    __syncthreads();
}


#ifndef DO_P2
#define DO_P2 1
#endif
#ifndef DO_P1A
#define DO_P1A 1
#endif
#ifndef P1B_MODE
#define P1B_MODE 1
#endif
#ifndef STOP_AFTER
#define STOP_AFTER 0
#endif
__device__ __forceinline__ void dump_bf16(float* out, const bf16* buf, int pitch, int ncols, int gw, int NGW, int lane) {
    for (int r = gw; r < MREAL; r += NGW) for (int c = lane; c < 1024; c += 64) out[(size_t)r * 1024 + c] = __builtin_bit_cast(float, (unsigned)buf[(size_t)r * pitch + (c % ncols)] << 16);
}
#define STOP(k, buf, pitch, ncols) do { if (STOP_AFTER == (k)) { GSYNC(); if ((buf) != nullptr) dump_bf16(a.out, (const bf16*)(buf), pitch, ncols, gw, NGW, lane); return; } } while (0)
#ifndef USE_CG_SYNC
#define USE_CG_SYNC 1
#endif
__global__ void __launch_bounds__(512, 2) fwd_kernel(Args a) {
    extern __shared__ __attribute__((aligned(16))) unsigned char lds_raw[];
    LAS unsigned char* lds = (LAS unsigned char*)lds_raw;
    cg::grid_group grid = cg::this_grid();
    const int tid = threadIdx.x, lane = tid & 63, wave = __builtin_amdgcn_readfirstlane(tid >> 6);
    const int G = gridDim.x, bx = blockIdx.x;
    const int gw = bx * 8 + wave, NGW = G * 8;
    unsigned char* ws = a.ws;
    bf16* XB = (bf16*)(ws + WS_XB); bf16* RA = (bf16*)(ws + WS_A); bf16* RB = (bf16*)(ws + WS_B); bf16* DBUF = (bf16*)(ws + WS_B + SZ_XB);
    float* XFM = (float*)(ws + WS_XFM);
    for (int u = tid; u < (LDS_BYTES - 131072) / 4; u += 512) ((LAS unsigned*)(lds + 131072))[u] = 0u;
    __syncthreads();
    XcdBarrier bar = xcd_barrier_post((unsigned*)(ws + WS_CTL) + 4096, (volatile LAS unsigned*)(lds + 131072 + 320) + 8);
#define GSYNC() do { xcd_barrier(bar); } while (0)
#define XF_ROW(r) ((r) < MREAL ? a.out + (size_t)(r) * D : XFM + (size_t)((r) - MREAL) * D)

    convert_weights(a, 0, lds, gw, NGW, wave, lane);
    for (int r = gw; r < MROWS; r += NGW) {
        const float* src = r < 16384 ? a.xp + (size_t)r * D : (r < MREAL ? a.xs + (size_t)(r - 16384) * D : a.meta + (size_t)((r - MREAL) & 15) * D);
        ln_row(src, XF_ROW(r), XB + (size_t)r * D, a.lneg, a.lneb, lane);
    }
    asm volatile("s_waitcnt vmcnt(0)" ::: "memory"); grid.sync();
    GSYNC();

#define LAYER_BODY(l) do { \
        if (DO_P1A) { pg8::Gemm g{XB, (const bf16*)(ws + WS_WIN), MP, 2048, D}; pg8::StaticOrder S; S.init(MP, 2048, G, bx); \
          pg8::EpiB<0> E{RA, PJ, nullptr, nullptr, 0, 0, QSCALE, 4}; \
          pg8::gemm_phase<pg8::EpiB<0>, pg8::StaticOrder, true, true>(lds, g, S, E); } \
        GSYNC(); \
        if ((l) == 0) { STOP(1, RA, PJ, 1024); } \
        if (DO_P2) { const float* sink_l = a.sink + l * 16; \
          for (int u = bx; u < 1024 + 24; u += G) { \
              int s, n, kh; \
              if (u < 1024) { const int blk = u >> 2; kh = u & 3; const int row = blk * 128; if (row < 16384) { s = row >> 13; n = (row & 8191) >> 7; } else { s = 2 + ((row - 16384) >> 12); n = ((row - 16384) & 4095) >> 7; } } \
              else { const int v = u - 1024; s = v >> 2; kh = v & 3; n = -1; } \
              attn_unit(lds, RA, RB, DBUF, sink_l, s, n, kh); \
          } } \
        GSYNC(); \
        if ((l) == 0) { STOP(2, RB, D, 1024); STOP(22, DBUF, 512, 512); } \
        { pg8::Gemm g{XB, (const bf16*)(ws + WS_WIN) + (size_t)2048 * D, MP, 2048, D}; pg8::StaticOrder S; S.init(MP, 2048, G, bx); \
          pg8::EpiB<P1B_MODE> E{RA, PJ, nullptr, nullptr, 0, 0, 1.f, 0}; \
          pg8::gemm_phase<pg8::EpiB<P1B_MODE>, pg8::StaticOrder, true, true>(lds, g, S, E); } \
        GSYNC(); \
        if ((l) == 0) { STOP(3, RA, PJ, 1024); } \
        { pg8::Gemm g{RB, (const bf16*)(ws + WS_WA), MP, D, D}; pg8::StaticOrder S; S.init(MP, D, G, bx); \
          pg8::EpiB<3> E{XB, D, nullptr, RA, PJ, 0, 1.f, 0}; \
          pg8::gemm_phase<pg8::EpiB<3>, pg8::StaticOrder, true, true>(lds, g, S, E); } \
        GSYNC(); \
        if ((l) == 0) { STOP(4, XB, D, 1024); } \
        { pg8::Gemm g{DBUF, (const bf16*)(ws + WS_WP), MP, D, 512}; pg8::StaticOrder S; S.init(MP, D, G, bx); \
          pg8::EpiB<4> E{XB, D, nullptr, RA, PJ, 1024, 1.f, 0}; \
          pg8::gemm_phase<pg8::EpiB<4>, pg8::StaticOrder, true, true>(lds, g, S, E); } \
        GSYNC(); \
        if ((l) == 0) { STOP(5, XB, D, 1024); } \
        { pg8::Gemm g{XB, (const bf16*)(ws + WS_WOUT), MP, D, D}; pg8::StaticOrder S; S.init(MP, D, G, bx); \
          pg8::EpiRes E{a.out, XFM, MREAL, D, nullptr, ALPHA}; \
          pg8::gemm_phase<pg8::EpiRes, pg8::StaticOrder, true, true>(lds, g, S, E); } \
        GSYNC(); \
        if ((l) == 0) { STOP(6, (const bf16*)nullptr, 0, 1); } \
        for (int r = gw; r < MROWS; r += NGW) ln_row(XF_ROW(r), XF_ROW(r), XB + (size_t)r * D, a.ln1g + l * D, a.ln1b + l * D, lane); \
        GSYNC(); \
        if ((l) == 0) { STOP(7, XB, D, 1024); } \
        { pg8::Gemm g{XB, (const bf16*)(ws + WS_W1), MP, DFF, D}; pg8::StaticOrder S; S.init(MP, DFF, G, bx); \
          pg8::EpiB<2> E{RA, DFF, a.b1 + l * DFF, nullptr, 0, 0, 1.f, 0}; \
          pg8::gemm_phase<pg8::EpiB<2>, pg8::StaticOrder, true, true>(lds, g, S, E); } \
        GSYNC(); \
        if ((l) == 0) { STOP(8, RA, DFF, 1024); } \
        { pg8::Gemm g{RA, (const bf16*)(ws + WS_W2), MP, D, DFF}; pg8::StaticOrder S; S.init(MP, D, G, bx); \
          pg8::EpiRes E{a.out, XFM, MREAL, D, a.b2 + l * D, ALPHA}; \
          pg8::gemm_phase<pg8::EpiRes, pg8::StaticOrder, true, true>(lds, g, S, E); } \
        GSYNC(); \
        if ((l) == 0) { STOP(9, (const bf16*)nullptr, 0, 1); } \
        for (int r = gw; r < MROWS; r += NGW) ln_row(XF_ROW(r), XF_ROW(r), XB + (size_t)r * D, a.ln2g + l * D, a.ln2b + l * D, lane); \
        if (l + 1 < DEPTH) { convert_weights(a, l + 1, lds, gw, NGW, wave, lane); GSYNC(); } \
} while (0)
    LAYER_BODY(0); LAYER_BODY(1); LAYER_BODY(2); LAYER_BODY(3);
}

extern "C" void kernel_launch(void* const* d_in, const int* in_sizes, int n_in, void* d_out, int out_size, void* d_ws, size_t ws_size, hipStream_t stream) {
    static int grid = 0;
    if (grid == 0) {
        if (n_in != 20 || out_size != MREAL * D || ws_size < WS_END) { fprintf(stderr, "kernel_launch: unexpected shapes: n_in %d out %d ws %zu (need %zu)\n", n_in, out_size, ws_size, (size_t)WS_END); grid = -1; return; }
        int dev = 0, cus = 0, per_cu = 0;
        hipGetDevice(&dev); hipDeviceGetAttribute(&cus, hipDeviceAttributeMultiprocessorCount, dev);
        if (hipFuncSetAttribute((const void*)fwd_kernel, hipFuncAttributeMaxDynamicSharedMemorySize, LDS_BYTES) != hipSuccess) { fprintf(stderr, "kernel_launch: hipFuncSetAttribute failed\n"); grid = -1; return; }
        hipOccupancyMaxActiveBlocksPerMultiprocessor(&per_cu, (const void*)fwd_kernel, 512, LDS_BYTES);
        (void)hipGetLastError();
        if (per_cu < 1) fprintf(stderr, "kernel_launch: occupancy query says %d blocks per CU\n", per_cu);
        grid = cus;
    }
    if (grid < 0) return;
    hipMemsetAsync((char*)d_ws + WS_CTL, 0, 1 * MiB, stream);
    Args a{};
    const float** f = (const float**)&a;
    for (int i = 0; i < 20; ++i) f[i] = (const float*)d_in[i];
    a.out = (float*)d_out; a.ws = (unsigned char*)d_ws;
    void* args[] = {&a};
    hipError_t e = hipLaunchCooperativeKernel((const void*)fwd_kernel, dim3(grid), dim3(512), args, LDS_BYTES, stream);
    if (e != hipSuccess) fprintf(stderr, "kernel_launch: cooperative launch failed: %s (grid %d)\n", hipGetErrorString(e), grid);
}
```

```cpp
#define STOP_AFTER 0
#include <hip/hip_runtime.h>
#include <hip/hip_cooperative_groups.h>
#include <cstdio>
#include <cstdint>
#include <cmath>
namespace cg = cooperative_groups;
namespace pg8 {
#define PG8_LAS __attribute__((address_space(3)))
typedef unsigned short bf16_t;
typedef short bf16x8 __attribute__((ext_vector_type(8)));
typedef float f32x4 __attribute__((ext_vector_type(4)));
typedef unsigned u32x4 __attribute__((ext_vector_type(4)));
constexpr int BM = 256, BK = 64, HALF = 128, HTB = HALF * BK * 2  , STAGE_BYTES = 8 * HTB, NXCD = 8, WGM = 8;

__host__ __device__ __forceinline__ int lds_byte(int r, int c) { const int st = (r >> 4) * 2 + (c >> 5), rr = r & 15, cc = c & 31, ob = rr * 64 + cc * 2; return st * 1024 + (ob ^ (((ob >> 9) & 1) << 5)); }
__host__ __device__ __forceinline__ void stage_rc(int b, int& R, int& C) { const int st = b / 1024, sb = b % 1024, swz = sb ^ (((sb >> 9) & 1) << 5); R = (st >> 1) * 16 + swz / 64; C = (st & 1) * 32 + (swz % 64) / 2; }
__host__ __device__ __forceinline__ int perm32(int rho) { const int n = rho >> 4, i = rho & 15; return 8 * (i >> 2) + 4 * n + (i & 3); }

struct Unit { int pm, pn; };
struct Gemm { const bf16_t* A; const bf16_t* Bt; int M, N, K; };

struct StaticOrder {
    int nM, nN, nwg, G, c;
    __host__ __device__ void init(int M, int N, int G_, int c_) { nM = M / BM; nN = N / BM; nwg = nM * nN; G = G_; c = c_; }
    __host__ __device__ bool next(int i, Unit& u) const {
        const long L = (long)i * G + c; if (L >= nwg) return false;
        int wgid = (int)L; { const int q = nwg / NXCD, r = nwg % NXCD, xcd = wgid % NXCD, off = wgid / NXCD; wgid = (xcd < r ? xcd * (q + 1) : r * (q + 1) + (xcd - r) * q) + off; }
        const int nig = WGM * nN, gid = wgid / nig, fm = gid * WGM, gsz = (nM - fm) < WGM ? (nM - fm) : WGM;
        u.pm = fm + ((wgid % nig) % gsz); u.pn = (wgid % nig) / gsz; return true;
    }
    __device__ __forceinline__ void a_ready(const Unit&) const {}
    __device__ __forceinline__ void done(const Unit&) const {}
};

typedef float f32x2_cv __attribute__((ext_vector_type(2))); typedef __bf16 bf16x2_cv __attribute__((ext_vector_type(2)));
__device__ __forceinline__ unsigned cvt_pk_bf16(float lo, float hi) { f32x2_cv v = {lo, hi}; bf16x2_cv b = __builtin_convertvector(v, bf16x2_cv); return __builtin_bit_cast(unsigned, b); }
typedef float f32x2 __attribute__((ext_vector_type(2)));
typedef unsigned u32x4 __attribute__((ext_vector_type(4)));
__device__ __forceinline__ float bf_lo(unsigned w) { return __builtin_bit_cast(float, w << 16); }
__device__ __forceinline__ float bf_hi(unsigned w) { return __builtin_bit_cast(float, w & 0xffff0000u); }
__device__ __forceinline__ u32x4 pack8(f32x4 a, f32x4 b) { u32x4 w; w.x = cvt_pk_bf16(a[0], a[1]); w.y = cvt_pk_bf16(a[2], a[3]); w.z = cvt_pk_bf16(b[0], b[1]); w.w = cvt_pk_bf16(b[2], b[3]); return w; }
__device__ __forceinline__ void unpack8(u32x4 w, f32x4& a, f32x4& b) { a = (f32x4){bf_lo(w.x), bf_hi(w.x), bf_lo(w.y), bf_hi(w.y)}; b = (f32x4){bf_lo(w.z), bf_hi(w.z), bf_lo(w.w), bf_hi(w.w)}; }
__device__ __forceinline__ float sigm(float x) { return __builtin_amdgcn_rcpf(1.0f + __builtin_amdgcn_exp2f(x * -1.4426950408889634f)); }

template <int MODE> struct EpiB {
    static constexpr bool PERM = true, AFTER_DRAIN = false;
    bf16_t* O; int ldc; const float* bias; const bf16_t* G; int ldg; int gcol0; float scale0; int scale_tiles;
    __device__ __forceinline__ void operator()(const f32x4 (&acc)[2][2][4][2], const Unit& u, int wr, int wc, int fr, int fq) const {
        const int row0 = u.pm * BM + wr * 64 + fr; const int col0 = u.pn * BM + wc * 32 + 8 * fq;
        const float sc = (MODE == 0 && u.pn < scale_tiles) ? scale0 : 1.0f;
        f32x4 bv[2][2];
        if (MODE == 2) {
#pragma unroll
            for (int bj = 0; bj < 2; ++bj)
#pragma unroll
                for (int n = 0; n < 2; ++n) bv[bj][n] = *(const f32x4*)(bias + col0 + bj * HALF + 4 * n);
        }
#pragma unroll
        for (int ai = 0; ai < 2; ++ai)
#pragma unroll
            for (int m = 0; m < 4; ++m) { const size_t row = (size_t)(row0 + ai * HALF + m * 16); bf16_t* rowp = O + row * ldc + col0;
#pragma unroll
                for (int bj = 0; bj < 2; ++bj) { f32x4 v0 = acc[ai][bj][m][0], v1 = acc[ai][bj][m][1];
                    if (MODE == 0) { v0 = v0 * sc; v1 = v1 * sc; }
                    if (MODE == 1) { v0 = (f32x4){sigm(v0[0]), sigm(v0[1]), sigm(v0[2]), sigm(v0[3])}; v1 = (f32x4){sigm(v1[0]), sigm(v1[1]), sigm(v1[2]), sigm(v1[3])}; }
                    if (MODE == 2) { v0 = v0 + bv[bj][0]; v1 = v1 + bv[bj][1]; v0 = __builtin_elementwise_max(v0, (f32x4){0.f, 0.f, 0.f, 0.f}); v1 = __builtin_elementwise_max(v1, (f32x4){0.f, 0.f, 0.f, 0.f}); v0 = v0 * v0; v1 = v1 * v1; }
                    if (MODE == 3 || MODE == 4) { const u32x4 gw = *(const u32x4*)(G + row * ldg + gcol0 + col0 + bj * HALF); f32x4 g0, g1; unpack8(gw, g0, g1); v0 = v0 * g0; v1 = v1 * g1; }
                    if (MODE == 4) { const u32x4 ow = *(const u32x4*)(rowp + bj * HALF); f32x4 o0, o1; unpack8(ow, o0, o1); v0 = v0 + o0; v1 = v1 + o1; }
                    *(u32x4*)(rowp + bj * HALF) = pack8(v0, v1); }
                if (MODE >= 3) asm volatile("" ::: "memory"); }
    }
};
struct EpiRes {
    static constexpr bool PERM = false, AFTER_DRAIN = false;
    float* X; float* X2; int split_row; int ldc; const float* bias; float alpha;
    __device__ __forceinline__ void operator()(const f32x4 (&acc)[2][2][4][2], const Unit& u, int wr, int wc, int fr, int fq) const {
        const int col0 = u.pn * BM + wc * 32 + 4 * fq;
        float* base = (u.pm * BM >= split_row) ? X2 + (size_t)(u.pm * BM - split_row) * ldc : X + (size_t)(u.pm * BM) * ldc;
        f32x4 bv[2][2];
#pragma unroll
        for (int bj = 0; bj < 2; ++bj)
#pragma unroll
            for (int n = 0; n < 2; ++n) bv[bj][n] = bias ? *(const f32x4*)(bias + col0 + bj * HALF + n * 16) : (f32x4){0.f, 0.f, 0.f, 0.f};
#pragma unroll
        for (int ai = 0; ai < 2; ++ai)
#pragma unroll
            for (int m = 0; m < 4; ++m) { float* rowp = base + (size_t)(ai * HALF + wr * 64 + m * 16 + fr) * ldc + col0;
#pragma unroll
                for (int bj = 0; bj < 2; ++bj)
#pragma unroll
                    for (int n = 0; n < 2; ++n) { f32x4* p = (f32x4*)(rowp + bj * HALF + n * 16); const f32x4 x = *p; *p = x * alpha + (acc[ai][bj][m][n] + bv[bj][n]); }
                asm volatile("" ::: "memory"); }
    }
};

template <class Epi, class Sched, bool ALIGN_EPI = false, bool SP2 = false>
__device__ __forceinline__ void gemm_phase(PG8_LAS unsigned char* lds, const Gemm g, const Sched& S, const Epi& E) {
    int tid_ = threadIdx.x; asm volatile("" : "+v"(tid_));
    const int tid = tid_, wid = __builtin_amdgcn_readfirstlane(tid >> 6), lane = tid & 63, wr = wid >> 2, wc = wid & 3, fr = lane & 15, fq = lane >> 4;
    const int K = g.K, nt = K / BK;
    unsigned voffA[2], voffB[2];
#pragma unroll
    for (int i = 0; i < 2; ++i) { int R, C; stage_rc(tid * 16 + i * 8192, R, C); const int Rb = Epi::PERM ? ((R & ~31) + perm32(R & 31)) : R;
        voffA[i] = (unsigned)(R * K + C) * 2u; voffB[i] = (unsigned)(Rb * K + C) * 2u; }
    const size_t kstep = (size_t)(BK * 2);
    const size_t hstep = (size_t)HALF * K * 2;
    const size_t tstep = 2 * hstep;
    const unsigned ldsw = (unsigned)wid * 1024u;
    const int aoff = lds_byte(wr * 64 + fr, fq * 8), boff = lds_byte(wc * 32 + fr, fq * 8);
#define PG8_SA(b, h) (((b) * 2 + (h)) * HTB)
#define PG8_SB(b, h) ((4 + (b) * 2 + (h)) * HTB)
#define PG8_STAGE(bufoff, gbase, voff) do { _Pragma("unroll") for (int _i = 0; _i < 2; ++_i) \
        __builtin_amdgcn_global_load_lds((const unsigned*)((const char*)(gbase) + (voff)[_i]), (PG8_LAS unsigned*)(lds + (bufoff) + ldsw + _i * 8192), 16, 0, 0); } while (0)
#define PG8_LDA(dst, b, h) do { _Pragma("unroll") for (int m = 0; m < 4; ++m) _Pragma("unroll") for (int k = 0; k < 2; ++k) dst[m][k] = *(const PG8_LAS bf16x8*)(lds + PG8_SA(b, h) + aoff + m * 2048 + k * 1024); } while (0)
#define PG8_LDB(dst, b, h) do { _Pragma("unroll") for (int n = 0; n < 2; ++n) _Pragma("unroll") for (int k = 0; k < 2; ++k) dst[n][k] = *(const PG8_LAS bf16x8*)(lds + PG8_SB(b, h) + boff + n * 2048 + k * 1024); } while (0)
#define PG8_MMA(ai, bj, At, Bt) do { __builtin_amdgcn_s_setprio(1); _Pragma("unroll") for (int m = 0; m < 4; ++m) _Pragma("unroll") for (int n = 0; n < 2; ++n) _Pragma("unroll") for (int k = 0; k < 2; ++k) \
        acc[ai][bj][m][n] = __builtin_amdgcn_mfma_f32_16x16x32_bf16(Bt[n][k], At[m][k], acc[ai][bj][m][n], 0, 0, 0); __builtin_amdgcn_s_setprio(0); } while (0)
#define PG8_WAIT_V(n) asm volatile("s_waitcnt vmcnt(" #n ")" ::: "memory")
#define PG8_WAIT_L(n) asm volatile("s_waitcnt lgkmcnt(" #n ")" ::: "memory")
#define PG8_BAR __builtin_amdgcn_s_barrier()
#define PG8_SCHED __builtin_amdgcn_sched_barrier(0)
    Unit cur, nxt; int ui = 0;
    if (!S.next(0, cur)) return;
    f32x4 acc[2][2][4][2];
#pragma unroll
    for (int a = 0; a < 2; ++a)
#pragma unroll
        for (int b = 0; b < 2; ++b)
#pragma unroll
            for (int m = 0; m < 4; ++m)
#pragma unroll
                for (int n = 0; n < 2; ++n) acc[a][b][m][n] = (f32x4){0.f, 0.f, 0.f, 0.f};
    bf16x8 At[4][2], B0[2][2], B1[2][2];
    const char* cA = (const char*)g.A + (size_t)cur.pm * tstep; const char* cB = (const char*)g.Bt + (size_t)cur.pn * tstep;
    S.a_ready(cur);
    if constexpr (SP2) {
        PG8_STAGE(PG8_SB(0, 0), cB, voffB); PG8_STAGE(PG8_SB(0, 1), cB + hstep, voffB); PG8_STAGE(PG8_SA(0, 0), cA, voffA); PG8_STAGE(PG8_SA(0, 1), cA + hstep, voffA);
        if (wr == 1) PG8_BAR;
        PG8_WAIT_V(2); PG8_BAR;
        PG8_STAGE(PG8_SB(1, 0), cB + kstep, voffB); PG8_STAGE(PG8_SA(1, 0), cA + kstep, voffA); PG8_STAGE(PG8_SB(1, 1), cB + hstep + kstep, voffB);
        PG8_WAIT_V(6); PG8_BAR;
    } else {
        PG8_STAGE(PG8_SB(0, 0), cB, voffB); PG8_STAGE(PG8_SA(0, 0), cA, voffA); PG8_STAGE(PG8_SB(0, 1), cB + hstep, voffB); PG8_STAGE(PG8_SA(0, 1), cA + hstep, voffA);
        if (wr == 1) PG8_BAR;
        PG8_WAIT_V(4); PG8_BAR;
        PG8_STAGE(PG8_SB(1, 0), cB + kstep, voffB); PG8_STAGE(PG8_SA(1, 0), cA + kstep, voffA); PG8_STAGE(PG8_SB(1, 1), cB + hstep + kstep, voffB);
        PG8_WAIT_V(6); PG8_BAR;
    }
    for (;;) {
        const bool has_next = S.next(ui + 1, nxt);
        const char* nA = has_next ? (const char*)g.A + (size_t)nxt.pm * tstep : cA; const char* nB = has_next ? (const char*)g.Bt + (size_t)nxt.pn * tstep : cB;
        for (int t = 0; t < nt; t += 2) {
            const bool last = (t == nt - 2);
            const char* a1 = cA + (size_t)(t + 1) * kstep;
            const char* a2 = last ? nA : cA + (size_t)(t + 2) * kstep; const char* b2 = last ? nB : cB + (size_t)(t + 2) * kstep;
            const char* a3 = a2 + kstep; const char* b3 = b2 + kstep;
            if (last && has_next) S.a_ready(nxt);
            if constexpr (SP2) {
            PG8_LDB(B0, 0, 0); PG8_LDB(B1, 0, 1); PG8_SCHED; PG8_LDA(At, 0, 0); PG8_STAGE(PG8_SA(1, 1), a1 + hstep, voffA);
            PG8_WAIT_V(8); PG8_WAIT_L(0); PG8_BAR; PG8_MMA(0, 0, At, B0); PG8_MMA(0, 1, At, B1); PG8_BAR; PG8_SCHED;
            PG8_LDA(At, 0, 1); PG8_STAGE(PG8_SB(0, 0), b2, voffB); PG8_STAGE(PG8_SB(0, 1), b2 + hstep, voffB); PG8_STAGE(PG8_SA(0, 0), a2, voffA);
            PG8_WAIT_V(8); PG8_WAIT_L(0); PG8_BAR; PG8_MMA(1, 0, At, B0); PG8_MMA(1, 1, At, B1); PG8_BAR; PG8_SCHED;
            PG8_LDB(B0, 1, 0); PG8_LDB(B1, 1, 1); PG8_SCHED; PG8_LDA(At, 1, 0); PG8_STAGE(PG8_SA(0, 1), a2 + hstep, voffA);
            PG8_WAIT_V(8); PG8_WAIT_L(0); PG8_BAR; PG8_MMA(0, 0, At, B0); PG8_MMA(0, 1, At, B1); PG8_BAR; PG8_SCHED;
            PG8_LDA(At, 1, 1); PG8_STAGE(PG8_SB(1, 0), b3, voffB); PG8_STAGE(PG8_SB(1, 1), b3 + hstep, voffB); PG8_STAGE(PG8_SA(1, 0), a3, voffA);
            PG8_WAIT_V(8); PG8_WAIT_L(0); PG8_BAR; PG8_MMA(1, 0, At, B0); PG8_MMA(1, 1, At, B1); PG8_BAR; PG8_SCHED;
            } else {
            PG8_LDB(B0, 0, 0); PG8_SCHED; PG8_LDA(At, 0, 0); PG8_STAGE(PG8_SA(1, 1), a1 + hstep, voffA);
            PG8_WAIT_L(8); PG8_BAR; PG8_WAIT_L(0); PG8_MMA(0, 0, At, B0); PG8_BAR; PG8_SCHED;
            PG8_LDB(B1, 0, 1); PG8_STAGE(PG8_SB(0, 0), b2, voffB);
            PG8_BAR; PG8_WAIT_L(0); PG8_MMA(0, 1, At, B1); PG8_BAR;
            PG8_LDA(At, 0, 1); PG8_STAGE(PG8_SA(0, 0), a2, voffA);
            PG8_BAR; PG8_WAIT_L(0); PG8_MMA(1, 0, At, B0); PG8_BAR; PG8_SCHED;
            PG8_STAGE(PG8_SB(0, 1), b2 + hstep, voffB);
            PG8_WAIT_V(6); PG8_BAR; PG8_MMA(1, 1, At, B1); PG8_BAR;
            PG8_LDB(B0, 1, 0); PG8_SCHED; PG8_LDA(At, 1, 0); PG8_STAGE(PG8_SA(0, 1), a2 + hstep, voffA);
            PG8_WAIT_L(8); PG8_BAR; PG8_WAIT_L(0); PG8_MMA(0, 0, At, B0); PG8_BAR; PG8_SCHED;
            PG8_LDB(B1, 1, 1); PG8_STAGE(PG8_SB(1, 0), b3, voffB);
            PG8_BAR; PG8_WAIT_L(0); PG8_MMA(0, 1, At, B1); PG8_BAR;
            PG8_LDA(At, 1, 1); PG8_STAGE(PG8_SA(1, 0), a3, voffA);
            PG8_BAR; PG8_WAIT_L(0); PG8_MMA(1, 0, At, B0); PG8_BAR; PG8_SCHED;
            PG8_STAGE(PG8_SB(1, 1), b3 + hstep, voffB);
            PG8_WAIT_V(6); PG8_BAR; PG8_MMA(1, 1, At, B1); PG8_BAR;
            }
        }
        if constexpr (ALIGN_EPI) { if (wr == 0) PG8_BAR; }
        if constexpr (!Epi::AFTER_DRAIN) { E(acc, cur, wr, wc, fr, fq); S.done(cur); }
        if (!has_next) break;
#pragma unroll
        for (int a = 0; a < 2; ++a)
#pragma unroll
            for (int b = 0; b < 2; ++b)
#pragma unroll
                for (int m = 0; m < 4; ++m)
#pragma unroll
                    for (int n = 0; n < 2; ++n) acc[a][b][m][n] = (f32x4){0.f, 0.f, 0.f, 0.f};
        cur = nxt; cA = nA; cB = nB; ++ui;
        if constexpr (ALIGN_EPI) { if (wr == 1) PG8_BAR; }
    }
    PG8_WAIT_V(0);
    if constexpr (!ALIGN_EPI) { if (wr == 0) PG8_BAR; }
    PG8_BAR;
    if constexpr (Epi::AFTER_DRAIN) { E.fused(acc, cur, wr, wc, fr, fq, lds, wid, lane); S.done(cur); }
#undef PG8_SA
#undef PG8_SB
#undef PG8_STAGE
#undef PG8_LDA
#undef PG8_LDB
#undef PG8_MMA
#undef PG8_WAIT_V
#undef PG8_WAIT_L
#undef PG8_BAR
#undef PG8_SCHED
}
}
#define GAS __attribute__((address_space(1)))
#define LAS __attribute__((address_space(3)))
typedef unsigned short bf16;
typedef unsigned v4u __attribute__((ext_vector_type(4)));
typedef float f32x4 __attribute__((ext_vector_type(4)));
typedef short bf16x8 __attribute__((ext_vector_type(8)));
typedef GAS unsigned gu32;
typedef GAS unsigned long long gu64;
#define RLX_AGENT __ATOMIC_RELAXED, __HIP_MEMORY_SCOPE_AGENT
#define LDS_WAIT() asm volatile("s_waitcnt lgkmcnt(0)" ::: "memory")
#define VM_WAIT() asm volatile("s_waitcnt vmcnt(0)" ::: "memory")
__device__ __forceinline__ unsigned long long rt() { return __builtin_amdgcn_s_memrealtime(); }
__device__ __forceinline__ unsigned f2bf(float f) { unsigned u = __builtin_bit_cast(unsigned, f); return (u + 0x7fffu + ((u >> 16) & 1u)) >> 16; }
__device__ __forceinline__ unsigned pk2(float lo, float hi) { return f2bf(lo) | (f2bf(hi) << 16); }

#define XB_TMO      128
#define XB_XCNT(j)  (256  + 64 * (j))
#define XB_XSUB(j)  (1280 + 64 * (j))
#define XB_XGEN(j)  (2304 + 64 * (j))
#define XB_TOP      3328
#define XB_TOPGEN   3392
#define XCD_BAR_WORDS 3456
#define XB_SPIN_CAP (1u << 18)

__device__ __forceinline__ unsigned xb_ld(unsigned* p)              { return __hip_atomic_load(p, __ATOMIC_RELAXED, __HIP_MEMORY_SCOPE_AGENT); }
__device__ __forceinline__ unsigned xb_add(unsigned* p, unsigned v) { return __hip_atomic_fetch_add(p, v, __ATOMIC_RELAXED, __HIP_MEMORY_SCOPE_AGENT); }
__device__ __forceinline__ unsigned xb_xcc_id() { return (unsigned)__builtin_amdgcn_s_getreg((3 << 11) | 20) & 0xFu; }
#define XB_SPIN(cond, bar) do { unsigned _sp = 0; while (cond) { __builtin_amdgcn_s_sleep(1); \
    if ((++_sp & 255u) == 0u) { if (xb_ld(&(bar)[XB_TMO])) break; if (_sp > XB_SPIN_CAP) { atomicAdd(&(bar)[XB_TMO], 1u); break; } } } } while (0)

struct XcdBarrier {
    unsigned* bar; unsigned x;
    volatile LAS unsigned* st;
};

__device__ __forceinline__ XcdBarrier xcd_barrier_post(unsigned* bar, volatile LAS unsigned* st) {
    XcdBarrier b; b.bar = bar; b.x = xb_xcc_id(); b.st = st;
    if (threadIdx.x == 0) (void)xb_add(&bar[XB_XCNT(b.x)], 1u);
    return b;
}
__device__ __forceinline__ void xcd_barrier_complete(unsigned* bar, unsigned x, unsigned& nloc, unsigned& nx) {
    const unsigned G = gridDim.x * gridDim.y * gridDim.z;
    unsigned sum, cnt, mine, sp = 0u;
    for (;;) {
        sum = 0u; cnt = 0u; mine = 0u;
#pragma unroll
        for (unsigned j = 0; j < 16; ++j) { const unsigned c = xb_ld(&bar[XB_XCNT(j)]); sum += c; cnt += (c > 0u) ? 1u : 0u; mine = (j == x) ? c : mine; }
        if (sum == G) break;
        __builtin_amdgcn_s_sleep(1);
        if ((++sp & 255u) == 0u) { if (xb_ld(&bar[XB_TMO])) break; if (sp > XB_SPIN_CAP) { atomicAdd(&bar[XB_TMO], 1u); break; } }
    }
    nloc = mine > 0u ? mine : 1u; nx = cnt > 0u ? cnt : 1u;
}

__device__ __forceinline__ void xcd_barrier(const XcdBarrier& b) {
    asm volatile("s_waitcnt vmcnt(0)" ::: "memory");
    __syncthreads();
    if (threadIdx.x == 0) {
        unsigned* bar = b.bar;
        __builtin_amdgcn_s_waitcnt(0);
        unsigned nloc = b.st[0], nx = b.st[1];
        if (nloc == 0u) { xcd_barrier_complete(bar, b.x, nloc, nx); b.st[0] = nloc; b.st[1] = nx; }
        const unsigned old = xb_add(&bar[XB_XSUB(b.x)], 1u);
        const unsigned gen = old / nloc;
        if (old + 1u == (gen + 1u) * nloc) {
            __builtin_amdgcn_fence(__ATOMIC_RELEASE, "agent");
            asm volatile("s_waitcnt vmcnt(0)" ::: "memory");
            const unsigned og = xb_add(&bar[XB_TOP], 1u);
            const unsigned tg = og / nx;
            if (og + 1u == (tg + 1u) * nx) xb_add(&bar[XB_TOPGEN], 1u);
            else XB_SPIN(xb_ld(&bar[XB_TOPGEN]) == tg, bar);
            __builtin_amdgcn_fence(__ATOMIC_ACQUIRE, "agent");
            xb_add(&bar[XB_XGEN(b.x)], 1u);
            asm volatile("s_waitcnt vmcnt(0)" ::: "memory");
        } else {
            XB_SPIN(xb_ld(&bar[XB_XGEN(b.x)]) == gen, bar);
            __builtin_amdgcn_fence(__ATOMIC_ACQUIRE, "agent");
            asm volatile("s_waitcnt vmcnt(0)" ::: "memory");
        }
    }
    __syncthreads();
}

constexpr int D = 1024, DEPTH = 4, NSEQ = 6, NMETA = 16, DFF = 4096, INW = 4096;
constexpr int MREAL = 32768, MROWS = MREAL + NSEQ * NMETA  , MP = 33024  ;
constexpr float LN_EPS = 1e-5f;
constexpr float ALPHA = 1.6817928305074290f;
constexpr float LOG2E = 1.4426950408889634f;
constexpr float QSCALE = 0.125f * LOG2E;
constexpr int PJ = 2048, PJ_K = 1024, PJ_V = 1280, PJ_U = 1536;

constexpr size_t MiB = 1u << 20;
constexpr size_t WS_CTL = 0;
constexpr size_t WS_WIN = 1 * MiB, WS_WA = 9 * MiB, WS_WP = 11 * MiB, WS_WOUT = 12 * MiB, WS_W1 = 14 * MiB, WS_W2 = 22 * MiB;
constexpr size_t WS_XFM = 30 * MiB;
constexpr size_t WS_XB = 31 * MiB;
constexpr size_t SZ_XB = (size_t)MP * 1024 * 2;
constexpr size_t WS_A = WS_XB + SZ_XB;
constexpr size_t SZ_A = (size_t)MP * 2048 * 2;
constexpr size_t WS_B = WS_A + SZ_A;
constexpr size_t WS_END = WS_B + SZ_A;
constexpr int LDS_BYTES = 147456;

struct Args {
    const float *xp, *xs, *meta, *lneg, *lneb, *win, *sink, *wpool, *pscale, *wba, *wbp, *wout, *ln1g, *ln1b, *w1, *b1, *w2, *b2, *ln2g, *ln2b;
    float* out; unsigned char* ws;
};

__device__ __forceinline__ float wave_sum(float v) {
#pragma unroll
    for (int o = 1; o < 64; o <<= 1) v += __shfl_xor(v, o);
    return v;
}
__device__ __forceinline__ unsigned cvtpk(float lo, float hi) { return pg8::cvt_pk_bf16(lo, hi); }

__device__ __forceinline__ void transpose_item(const float* __restrict__ W, int K, int N, bf16* __restrict__ WT, LAS float* scr, int item, int lane) {
    const int nblk = N / 32, kb = item / nblk, nb = item % nblk, k0 = 64 * kb, n0 = 32 * nb;
    float wv[32];
#pragma unroll
    for (int i = 0; i < 32; ++i) wv[i] = W[(size_t)(k0 + 2 * i + (lane >> 5)) * N + n0 + (lane & 31)];
#pragma unroll
    for (int i = 0; i < 32; ++i) scr[(2 * i + (lane >> 5)) * 33 + (lane & 31)] = wv[i];
    LDS_WAIT(); asm volatile("" ::: "memory");
    const int c = lane & 7;
#pragma unroll
    for (int j = 0; j < 4; ++j) { const int n = (lane >> 3) + 8 * j; const LAS float* s = scr + (8 * c) * 33 + n;
        v4u o; o.x = cvtpk(s[0 * 33], s[1 * 33]); o.y = cvtpk(s[2 * 33], s[3 * 33]); o.z = cvtpk(s[4 * 33], s[5 * 33]); o.w = cvtpk(s[6 * 33], s[7 * 33]);
        *(v4u*)(WT + (size_t)(n0 + n) * K + k0 + 8 * c) = o; }
    LDS_WAIT(); asm volatile("" ::: "memory");
}

__device__ __forceinline__ void convert_weights(const Args& a, int l, LAS unsigned char* lds, int gw, int NGW, int wave, int lane) {
    unsigned char* ws = a.ws;
    LAS float* scr = (LAS float*)(lds + wave * 16384);
    constexpr int I_IN = (D / 64) * (INW / 32), I_SQ = (D / 64) * (D / 32), I_1 = (D / 64) * (DFF / 32), I_2 = (DFF / 64) * (D / 32);
    constexpr int NIT = I_IN + 2 * I_SQ + I_1 + I_2;
    for (int it = gw; it < NIT; it += NGW) {
        int r = it;
        if (r < I_IN) { transpose_item(a.win + (size_t)l * D * INW, D, INW, (bf16*)(ws + WS_WIN), scr, r, lane); continue; } r -= I_IN;
        if (r < I_SQ) { transpose_item(a.wba + (size_t)l * D * D, D, D, (bf16*)(ws + WS_WA), scr, r, lane); continue; } r -= I_SQ;
        if (r < I_SQ) { transpose_item(a.wout + (size_t)l * D * D, D, D, (bf16*)(ws + WS_WOUT), scr, r, lane); continue; } r -= I_SQ;
        if (r < I_1) { transpose_item(a.w1 + (size_t)l * D * DFF, D, DFF, (bf16*)(ws + WS_W1), scr, r, lane); continue; } r -= I_1;
        transpose_item(a.w2 + (size_t)l * DFF * D, DFF, D, (bf16*)(ws + WS_W2), scr, r, lane);
    }
    const float* wpool = a.wpool + (size_t)l * 4 * 128 * 128; const float* ps = a.pscale + (size_t)l * 512; const float* wbp = a.wbp + (size_t)l * 512 * D;
    bf16* WPT = (bf16*)(ws + WS_WP);
    for (int it = gw; it < 1024; it += NGW) {
        const int cch = it >> 4, n = ((it & 15) << 6) + lane; const int g = cch >> 4, c0 = (cch & 15) * 8;
        float acc[8];
#pragma unroll
        for (int e = 0; e < 8; ++e) acc[e] = 0.f;
        const float* wp = wpool + (size_t)(g * 128 + c0) * 128;
#pragma unroll 16
        for (int j = 0; j < 128; ++j) {
            const float w = ps[g * 128 + j] * wbp[(size_t)(g * 128 + j) * D + n];
#pragma unroll
            for (int e = 0; e < 8; ++e) acc[e] += wp[e * 128 + j] * w;
        }
        v4u o; o.x = cvtpk(acc[0], acc[1]); o.y = cvtpk(acc[2], acc[3]); o.z = cvtpk(acc[4], acc[5]); o.w = cvtpk(acc[6], acc[7]);
        *(v4u*)(WPT + (size_t)n * 512 + g * 128 + c0) = o;
    }
}

__device__ __forceinline__ void ln_row(const float* src, float* dstF, bf16* dstB, const float* __restrict__ g, const float* __restrict__ b, int lane) {
    const f32x4* xr = (const f32x4*)src + lane;
    f32x4 v[4]; float s = 0.f;
#pragma unroll
    for (int j = 0; j < 4; ++j) { v[j] = xr[64 * j]; s += (v[j].x + v[j].y) + (v[j].z + v[j].w); }
    const float mean = wave_sum(s) * (1.f / D); float s2 = 0.f;
#pragma unroll
    for (int j = 0; j < 4; ++j) { v[j] = v[j] - mean; s2 += (v[j].x * v[j].x + v[j].y * v[j].y) + (v[j].z * v[j].z + v[j].w * v[j].w); }
    const float rstd = 1.f / sqrtf(wave_sum(s2) * (1.f / D) + LN_EPS);
#pragma unroll
    for (int j = 0; j < 4; ++j) {
        const f32x4 gg = ((const f32x4*)g)[lane + 64 * j], bb = ((const f32x4*)b)[lane + 64 * j];
        const f32x4 y = v[j] * rstd * gg + bb;
        if (dstF) ((f32x4*)dstF)[lane + 64 * j] = y;
        typedef unsigned u32x2v __attribute__((ext_vector_type(2)));
        u32x2v w; w.x = cvtpk(y.x, y.y); w.y = cvtpk(y.z, y.w);
        ((u32x2v*)dstB)[lane + 64 * j] = w;
    }
}


template <int NB> __device__ __forceinline__ void ln_rows(const Args& a, float* XFM, bf16* XB, const float* __restrict__ g, const float* __restrict__ b, int gw, int NGW, int lane, float* dryF = nullptr) {
    for (int r0 = gw; r0 < MROWS; r0 += NB * NGW) {
        f32x4 v[NB][4]; float* rp[NB]; bool ok[NB];
#pragma unroll
        for (int i = 0; i < NB; ++i) { const int r = r0 + i * NGW; ok[i] = r < MROWS; const int rc = ok[i] ? r : r0; rp[i] = rc < MREAL ? a.out + (size_t)rc * D : XFM + (size_t)(rc - MREAL) * D;
#pragma unroll
            for (int j = 0; j < 4; ++j) v[i][j] = ((const f32x4*)rp[i])[lane + 64 * j]; }
#pragma unroll
        for (int i = 0; i < NB; ++i) {
            float s = 0.f;
#pragma unroll
            for (int j = 0; j < 4; ++j) s += (v[i][j].x + v[i][j].y) + (v[i][j].z + v[i][j].w);
            const float mean = wave_sum(s) * (1.f / D); float s2 = 0.f;
#pragma unroll
            for (int j = 0; j < 4; ++j) { v[i][j] = v[i][j] - mean; s2 += (v[i][j].x * v[i][j].x + v[i][j].y * v[i][j].y) + (v[i][j].z * v[i][j].z + v[i][j].w * v[i][j].w); }
            const float rstd = 1.f / sqrtf(wave_sum(s2) * (1.f / D) + LN_EPS);
            if (ok[i]) {
                const int r = r0 + i * NGW;
#pragma unroll
                for (int j = 0; j < 4; ++j) {
                    const f32x4 gg = ((const f32x4*)g)[lane + 64 * j], bb = ((const f32x4*)b)[lane + 64 * j];
                    const f32x4 y = v[i][j] * rstd * gg + bb;
                    if (dryF) ((f32x4*)(dryF + (size_t)r * D))[lane + 64 * j] = y; else ((f32x4*)rp[i])[lane + 64 * j] = y;
                    typedef unsigned u32x2v __attribute__((ext_vector_type(2)));
                    u32x2v w; w.x = cvtpk(y.x, y.y); w.y = cvtpk(y.z, y.w);
                    ((u32x2v*)(XB + (size_t)r * D))[lane + 64 * j] = w;
                }
            }
        }
    }
}

struct ThinP { bf16* O; int ldc; const float* bias; const bf16* G; int ldg; int gcol0; float* XF; float alpha; };
template <int MODE> __device__ __forceinline__ void thin_epi(const ThinP& P, int row, int col, f32x4 v) {
    typedef unsigned u32x2v __attribute__((ext_vector_type(2)));
    if (MODE == 5) { f32x4* p = (f32x4*)(P.XF + (size_t)(row - MREAL) * D + col); const f32x4 bv = P.bias ? *(const f32x4*)(P.bias + col) : (f32x4){0.f, 0.f, 0.f, 0.f}; *p = *p * P.alpha + (v + bv); return; }
    if (MODE == 0) { if (col < 1024) v = v * QSCALE; }
    if (MODE == 1) { v = (f32x4){pg8::sigm(v[0]), pg8::sigm(v[1]), pg8::sigm(v[2]), pg8::sigm(v[3])}; }
    if (MODE == 2) { v = v + *(const f32x4*)(P.bias + col); v = __builtin_elementwise_max(v, (f32x4){0.f, 0.f, 0.f, 0.f}); v = v * v; }
    bf16* op = P.O + (size_t)row * P.ldc + col;
    if (MODE == 3 || MODE == 4) { const u32x2v gw = *(const u32x2v*)(P.G + (size_t)row * P.ldg + P.gcol0 + col); v = v * (f32x4){pg8::bf_lo(gw.x), pg8::bf_hi(gw.x), pg8::bf_lo(gw.y), pg8::bf_hi(gw.y)}; }
    if (MODE == 4) { const u32x2v ow = *(const u32x2v*)op; v = v + (f32x4){pg8::bf_lo(ow.x), pg8::bf_hi(ow.x), pg8::bf_lo(ow.y), pg8::bf_hi(ow.y)}; }
    u32x2v w; w.x = cvtpk(v[0], v[1]); w.y = cvtpk(v[2], v[3]); *(u32x2v*)op = w;
}
template <int MODE> __device__ __forceinline__ void thin_gemm(LAS unsigned char* lds, const bf16* A, const bf16* Bt, int N, int K, const ThinP P) {
    int tid_ = threadIdx.x; asm volatile("" : "+v"(tid_));
    const int lane = tid_ & 63, wid = __builtin_amdgcn_readfirstlane(tid_ >> 6), fr = lane & 15, fq = lane >> 4;
    const int nct = N / 16, ks = K / 8, nst = ks / 32;
    LAS f32x4* red = (LAS f32x4*)lds;
    for (int ct = blockIdx.x; ct < nct; ct += gridDim.x) {
        f32x4 acc[6];
#pragma unroll
        for (int rt = 0; rt < 6; ++rt) acc[rt] = (f32x4){0.f, 0.f, 0.f, 0.f};
        const bf16* bp = Bt + (size_t)(ct * 16 + fr) * K + wid * ks + 8 * fq;
        const bf16* ap = A + (size_t)(MREAL + fr) * K + wid * ks + 8 * fq;
#pragma unroll 4
        for (int s = 0; s < nst; ++s) {
            const bf16x8 b = *(const bf16x8*)(bp + 32 * s);
            bf16x8 av[6];
#pragma unroll
            for (int rt = 0; rt < 6; ++rt) av[rt] = *(const bf16x8*)(ap + (size_t)rt * 16 * K + 32 * s);
#pragma unroll
            for (int rt = 0; rt < 6; ++rt) acc[rt] = __builtin_amdgcn_mfma_f32_16x16x32_bf16(b, av[rt], acc[rt], 0, 0, 0);
        }
#pragma unroll
        for (int rt = 0; rt < 6; ++rt) red[(wid * 6 + rt) * 64 + lane] = acc[rt];
        __syncthreads();
        if (wid < 6) {
            f32x4 v = red[wid * 64 + lane];
#pragma unroll
            for (int w = 1; w < 8; ++w) v += red[(w * 6 + wid) * 64 + lane];
            thin_epi<MODE>(P, MREAL + wid * 16 + fr, ct * 16 + 4 * fq, v);
        }
        __syncthreads();
    }
}

typedef float f32x16 __attribute__((ext_vector_type(16)));
typedef short s16x4 __attribute__((ext_vector_type(4)));
constexpr int AT_KROWS = 416, AT_ROWB = 128, AT_LDS_V = AT_KROWS * AT_ROWB;
__device__ __forceinline__ int at_koff(int row, int c) { return row * AT_ROWB + ((c ^ ((row >> 1) & 7)) << 4); }
__device__ __forceinline__ int at_voff(int row, int c) { return row * AT_ROWB + ((c ^ (((row >> 1) & 1) << 2)) << 4); }
__device__ __forceinline__ float half_max(float m) { auto rr = __builtin_amdgcn_permlane32_swap(__float_as_uint(m), __float_as_uint(m), false, false); return __builtin_fmaxf(__uint_as_float(rr[0]), __uint_as_float(rr[1])); }
__device__ __forceinline__ float half_sum(float m) { auto rr = __builtin_amdgcn_permlane32_swap(__float_as_uint(m), __float_as_uint(m), false, false); return __uint_as_float(rr[0]) + __uint_as_float(rr[1]); }
__device__ __forceinline__ s16x4 vtr(const LAS unsigned char* p) { typedef short v4i16_t __attribute__((ext_vector_type(4))); return __builtin_bit_cast(s16x4, __builtin_amdgcn_ds_read_tr16_b64_v4i16((LAS v4i16_t*)p)); }


template <int HALF> __device__ __forceinline__ void pool_items(const bf16* __restrict__ PROJ, bf16* __restrict__ DB, int kh, int p0, int nrows, int mb, int rb, int L, int tid) {
    constexpr int NW = 4 + 2 * HALF;
    for (int it = tid; it < (nrows >> 2) * 16; it += 512) {
        const int c = it & 15, pb = p0 + 4 * (it >> 4) - HALF;
        const bf16* ucol = PROJ + PJ_U + 128 * kh + 8 * c;
        v4u rw[NW];
#pragma unroll
        for (int j = 0; j < NW; ++j) { const int pos = pb + j; const bool valid = pos >= 0 && pos < L; const int pc = pos < 0 ? 0 : (pos >= L ? L - 1 : pos); const int row = pc < 16 ? mb + pc : rb + pc - 16;
            v4u w = *(const v4u*)(ucol + (size_t)row * PJ); if (!valid) w = (v4u){0u, 0u, 0u, 0u}; rw[j] = w; }
        f32x4 s0 = {0.f, 0.f, 0.f, 0.f}, s1 = {0.f, 0.f, 0.f, 0.f};
#pragma unroll
        for (int j = 0; j < 2 * HALF; ++j) { f32x4 x0, x1; pg8::unpack8(rw[j], x0, x1); s0 += x0; s1 += x1; }
#pragma unroll
        for (int r = 0; r < 4; ++r) {
            const int p = pb + HALF + r; const int lo = p - HALF < 0 ? 0 : p - HALF, hi_ = p + HALF > L ? L : p + HALF;
            const float inv = 1.0f / (float)(hi_ - lo);
            f32x4 c0, c1; pg8::unpack8(rw[HALF + r], c0, c1);
            const int prow = p < 16 ? mb + p : rb + p - 16;
            *(v4u*)(DB + (size_t)prow * 512 + 128 * kh + 8 * c) = pg8::pack8(s0 * inv - c0, s1 * inv - c1);
            if (r < 3) { f32x4 a0, a1, b0, b1; pg8::unpack8(rw[2 * HALF + r], a0, a1); pg8::unpack8(rw[r], b0, b1); s0 += a0 - b0; s1 += a1 - b1; }
        }
    }
}

__device__ __forceinline__ void attn_unit(LAS unsigned char* lds, const bf16* __restrict__ PROJ, bf16* __restrict__ AO, bf16* __restrict__ DB, const float* __restrict__ sink_l, int s, int n, int kh) {
    const int tid = threadIdx.x, lane = tid & 63, l31 = lane & 31, hi = lane >> 5;
    const int wid = __builtin_amdgcn_readfirstlane(tid >> 6);
    const int S = s < 2 ? 8192 : 4096, rb = s < 2 ? s * 8192 : 16384 + (s - 2) * 4096, mb = MREAL + 16 * s, L = S + 16;
    const int band_start = (n >= 0) ? 128 * (n - 1) : 0, band_len = (n >= 0) ? 384 : 128;
    {
        const int nblk = 2 + band_len / 8;
        for (int b = wid; b < nblk; b += 8) {
            int lrb, growb;
            if (b < 2) { lrb = 8 * b; growb = mb + 8 * b; }
            else { const int key = band_start + 8 * (b - 2); lrb = 32 + 8 * (b - 2); if (key < 0 || key >= S) continue; growb = rb + key; }
            const int lr = lrb + (lane >> 3), cp = lane & 7;
            const bf16* src = PROJ + (size_t)(growb + (lane >> 3)) * PJ + PJ_K + kh * 64;
            __builtin_amdgcn_global_load_lds((const unsigned*)(src + ((cp ^ ((lr >> 1) & 7)) << 3)), (LAS unsigned*)(lds + lrb * AT_ROWB), 16, 0, 0);
            __builtin_amdgcn_global_load_lds((const unsigned*)(src + (PJ_V - PJ_K) + ((cp ^ (((lr >> 1) & 1) << 2)) << 3)), (LAS unsigned*)(lds + AT_LDS_V + lrb * AT_ROWB), 16, 0, 0);
        }
    }
    {
        const int p0 = (n >= 0) ? 16 + 128 * n : 0, nrows = (n >= 0) ? 128 : 16;
        switch (kh) {
            case 0: pool_items<1>(PROJ, DB, kh, p0, nrows, mb, rb, L, tid); break;
            case 1: pool_items<2>(PROJ, DB, kh, p0, nrows, mb, rb, L, tid); break;
            case 2: pool_items<4>(PROJ, DB, kh, p0, nrows, mb, rb, L, tid); break;
            default: pool_items<8>(PROJ, DB, kh, p0, nrows, mb, rb, L, tid); break;
        }
    }
    asm volatile("s_waitcnt vmcnt(0)" ::: "memory");
    __syncthreads();
    const int g = (n >= 0) ? (wid >> 1) : (wid & 3);
    const int nsb = (n >= 0) ? 2 : (wid < 4 ? 1 : 0);
    const int h = kh * 4 + g;
    const float nsl = -__builtin_amdgcn_exp2f(-0.5f * (float)(h + 1)) * LOG2E;
    const float sinkl = sink_l[h] * LOG2E;
    const int L15 = lane & 15, g4 = (lane >> 4) & 1;
    for (int sb = 0; sb < nsb; ++sb) {
        const int q0 = (n >= 0) ? 128 * n + 64 * (wid & 1) + 32 * sb : -16;
        const int qpos = q0 + l31;
        const int qrow = qpos >= 0 ? rb + qpos : mb + 16 + qpos;
        const bool qvalid = (n >= 0) || (l31 < 16);
        bf16x8 qf[4];
#pragma unroll
        for (int d0 = 0; d0 < 4; ++d0) qf[d0] = *(const bf16x8*)(PROJ + (size_t)qrow * PJ + h * 64 + d0 * 16 + hi * 8);
        float m = sinkl, lsum = (hi == 0) ? 1.0f : 0.0f;
        f32x16 o0 = {}, o1 = {};
        const int vr = 4 * hi + (L15 >> 2), vc = 2 * g4 + ((L15 & 3) >> 1), vb = (L15 & 1) * 8;
        {
            f32x16 p = {};
#pragma unroll
            for (int d0 = 0; d0 < 4; ++d0) { const bf16x8 kf = *(const LAS bf16x8*)(lds + at_koff(l31, 2 * d0 + hi)); p = __builtin_amdgcn_mfma_f32_32x32x16_bf16(kf, qf[d0], p, 0, 0, 0); }
            float mx = p[0];
#pragma unroll
            for (int r = 1; r < 8; ++r) mx = __builtin_fmaxf(mx, p[r]);
            mx = half_max(mx);
            const float mn = __builtin_fmaxf(m, mx), al = __builtin_amdgcn_exp2f(m - mn); m = mn;
            float sum = 0.f;
#pragma unroll
            for (int r = 0; r < 8; ++r) { p[r] = __builtin_amdgcn_exp2f(p[r] - mn); sum += p[r]; }
            lsum = lsum * al + sum;
            v4u pw; pw.x = cvtpk(p[0], p[1]); pw.y = cvtpk(p[2], p[3]); pw.z = cvtpk(p[4], p[5]); pw.w = cvtpk(p[6], p[7]);
            const bf16x8 pf = __builtin_bit_cast(bf16x8, pw);
#pragma unroll
            for (int dt = 0; dt < 2; ++dt) {
                const s16x4 lo = vtr(lds + AT_LDS_V + at_voff(vr, 4 * dt + vc) + vb), hh = vtr(lds + AT_LDS_V + at_voff(vr + 8, 4 * dt + vc) + vb);
                const bf16x8 vf = (bf16x8){lo[0], lo[1], lo[2], lo[3], hh[0], hh[1], hh[2], hh[3]};
                if (dt == 0) o0 = __builtin_amdgcn_mfma_f32_32x32x16_bf16(vf, pf, o0, 0, 0, 0); else o1 = __builtin_amdgcn_mfma_f32_32x32x16_bf16(vf, pf, o1, 0, 0, 0);
            }
        }
        int klo = q0 - 128; if (klo < band_start) klo = band_start; if (klo < 0) klo = 0;
        int khi = q0 + 160; if (khi > band_start + band_len) khi = band_start + band_len; if (khi > S) khi = S;
        for (int k0 = klo; k0 < khi; k0 += 32) {
            const int lr0 = 32 + (k0 - band_start);
            f32x16 p = {};
#pragma unroll
            for (int d0 = 0; d0 < 4; ++d0) { const bf16x8 kf = *(const LAS bf16x8*)(lds + at_koff(lr0 + l31, 2 * d0 + hi)); p = __builtin_amdgcn_mfma_f32_32x32x16_bf16(kf, qf[d0], p, 0, 0, 0); }
            const float basef = (float)(k0 - qpos + 4 * hi);
            const bool need_mask = (k0 + 31 - q0 > 128) || (q0 + 31 - k0 > 128);
#pragma unroll
            for (int r = 0; r < 16; ++r) { const float t = basef + (float)((r & 3) + 8 * (r >> 2)); float sc = p[r] + nsl * __builtin_fabsf(t); if (need_mask && __builtin_fabsf(t) > 128.0f) sc = -INFINITY; p[r] = sc; }
            float mx = p[0];
#pragma unroll
            for (int r = 1; r < 16; ++r) mx = __builtin_fmaxf(mx, p[r]);
            mx = half_max(mx);
            const float mn = __builtin_fmaxf(m, mx), al = __builtin_amdgcn_exp2f(m - mn); m = mn;
            float sum = 0.f;
#pragma unroll
            for (int r = 0; r < 16; ++r) { p[r] = __builtin_amdgcn_exp2f(p[r] - mn); sum += p[r]; }
            lsum = lsum * al + sum;
#pragma unroll
            for (int r = 0; r < 16; ++r) { o0[r] *= al; o1[r] *= al; }
#pragma unroll
            for (int st = 0; st < 2; ++st) {
                v4u pw; pw.x = cvtpk(p[8 * st + 0], p[8 * st + 1]); pw.y = cvtpk(p[8 * st + 2], p[8 * st + 3]); pw.z = cvtpk(p[8 * st + 4], p[8 * st + 5]); pw.w = cvtpk(p[8 * st + 6], p[8 * st + 7]);
                const bf16x8 pf = __builtin_bit_cast(bf16x8, pw);
                const int row = lr0 + 16 * st + vr;
#pragma unroll
                for (int dt = 0; dt < 2; ++dt) {
                    const s16x4 lo = vtr(lds + AT_LDS_V + at_voff(row, 4 * dt + vc) + vb), hh = vtr(lds + AT_LDS_V + at_voff(row + 8, 4 * dt + vc) + vb);
                    const bf16x8 vf = (bf16x8){lo[0], lo[1], lo[2], lo[3], hh[0], hh[1], hh[2], hh[3]};
                    if (dt == 0) o0 = __builtin_amdgcn_mfma_f32_32x32x16_bf16(vf, pf, o0, 0, 0, 0); else o1 = __builtin_amdgcn_mfma_f32_32x32x16_bf16(vf, pf, o1, 0, 0, 0);
                }
            }
        }
        const float inv = 1.0f / half_sum(lsum);
        if (qvalid) {
            bf16* orow = AO + (size_t)qrow * D + h * 64 + 4 * hi;
            typedef unsigned u32x2v __attribute__((ext_vector_type(2)));
#pragma unroll
            for (int a4 = 0; a4 < 4; ++a4) {
                u32x2v w0; w0.x = cvtpk(o0[4 * a4] * inv, o0[4 * a4 + 1] * inv); w0.y = cvtpk(o0[4 * a4 + 2] * inv, o0[4 * a4 + 3] * inv);
                u32x2v w1; w1.x = cvtpk(o1[4 * a4] * inv, o1[4 * a4 + 1] * inv); w1.y = cvtpk(o1[4 * a4 + 2] * inv, o1[4 * a4 + 3] * inv);
                *(u32x2v*)(orow + 8 * a4) = w0; *(u32x2v*)(orow + 32 + 8 * a4) = w1;
            }
        }
    }
    __syncthreads();
}


#ifndef DO_P2
#define DO_P2 1
#endif
#ifndef DO_P1A
#define DO_P1A 1
#endif
#ifndef P1B_MODE
#define P1B_MODE 1
#endif
#ifndef REP_P2
#define REP_P2 1
#endif
#ifndef REP_P1A
#define REP_P1A 1
#endif
#define DRY_LN(l) do { ln_rows<4>(a, XFM, RB, a.ln1g + l * D, a.ln1b + l * D, gw, NGW, lane, (float*)RA); GSYNC(); } while (0)
#ifndef STOP_AFTER
#define STOP_AFTER 0
#endif
__device__ __forceinline__ void dump_bf16(float* out, const bf16* buf, int pitch, int ncols, int gw, int NGW, int lane) {
    for (int r = gw; r < MREAL; r += NGW) for (int c = lane; c < 1024; c += 64) out[(size_t)r * 1024 + c] = __builtin_bit_cast(float, (unsigned)buf[(size_t)r * pitch + (c % ncols)] << 16);
}
#define STOP(k, buf, pitch, ncols) do { if (STOP_AFTER == (k)) { GSYNC(); if ((buf) != nullptr) dump_bf16(a.out, (const bf16*)(buf), pitch, ncols, gw, NGW, lane); return; } } while (0)
#ifndef USE_CG_SYNC
#define USE_CG_SYNC 1
#endif
__global__ void __launch_bounds__(512, 2) fwd_kernel(Args a) {
    extern __shared__ __attribute__((aligned(16))) unsigned char lds_raw[];
    LAS unsigned char* lds = (LAS unsigned char*)lds_raw;
    cg::grid_group grid = cg::this_grid();
    const int tid = threadIdx.x, lane = tid & 63, wave = __builtin_amdgcn_readfirstlane(tid >> 6);
    const int G = gridDim.x, bx = blockIdx.x;
    const int gw = bx * 8 + wave, NGW = G * 8;
    unsigned char* ws = a.ws;
    bf16* XB = (bf16*)(ws + WS_XB); bf16* RA = (bf16*)(ws + WS_A); bf16* RB = (bf16*)(ws + WS_B); bf16* DBUF = (bf16*)(ws + WS_B + SZ_XB);
    float* XFM = (float*)(ws + WS_XFM);
    for (int u = tid; u < (LDS_BYTES - 131072) / 4; u += 512) ((LAS unsigned*)(lds + 131072))[u] = 0u;
    __syncthreads();
    XcdBarrier bar = xcd_barrier_post((unsigned*)(ws + WS_CTL) + 4096, (volatile LAS unsigned*)(lds + 131072 + 320) + 8);
#define GSYNC() do { xcd_barrier(bar); } while (0)
#define XF_ROW(r) ((r) < MREAL ? a.out + (size_t)(r) * D : XFM + (size_t)((r) - MREAL) * D)

    convert_weights(a, 0, lds, gw, NGW, wave, lane);
    for (int r = gw; r < MROWS; r += NGW) {
        const float* src = r < 16384 ? a.xp + (size_t)r * D : (r < MREAL ? a.xs + (size_t)(r - 16384) * D : a.meta + (size_t)((r - MREAL) & 15) * D);
        ln_row(src, XF_ROW(r), XB + (size_t)r * D, a.lneg, a.lneb, lane);
    }
    asm volatile("s_waitcnt vmcnt(0)" ::: "memory"); grid.sync();
    GSYNC();

#define PH_P1A(l) do { \
        if (DO_P1A) { pg8::Gemm g{XB, (const bf16*)(ws + WS_WIN), MREAL, 2048, D}; pg8::StaticOrder S; S.init(MREAL, 2048, G, bx); \
          pg8::EpiB<0> E{RA, PJ, nullptr, nullptr, 0, 0, QSCALE, 4}; \
          pg8::gemm_phase<pg8::EpiB<0>, pg8::StaticOrder, true, true>(lds, g, S, E); \
          thin_gemm<0>(lds, XB, (const bf16*)(ws + WS_WIN), 2048, D, ThinP{RA, PJ, nullptr, nullptr, 0, 0, nullptr, 0.f}); } \
        GSYNC(); \
} while (0)
#define PH_P2(l) do { \
        if ((l) == 0) { STOP(1, RA, PJ, 1024); } \
        if (DO_P2) { const float* sink_l = a.sink + l * 16; \
          for (int u = bx; u < 1024 + 24; u += G) { \
              int s, n, kh; \
              if (u < 1024) { const int blk = u >> 2; kh = u & 3; const int row = blk * 128; if (row < 16384) { s = row >> 13; n = (row & 8191) >> 7; } else { s = 2 + ((row - 16384) >> 12); n = ((row - 16384) & 4095) >> 7; } } \
              else { const int v = u - 1024; s = v >> 2; kh = v & 3; n = -1; } \
              attn_unit(lds, RA, RB, DBUF, sink_l, s, n, kh); \
          } } \
        GSYNC(); \
} while (0)
#define PH_P1B(l) do { \
        if ((l) == 0) { STOP(2, RB, D, 1024); STOP(22, DBUF, 512, 512); } \
        { pg8::Gemm g{XB, (const bf16*)(ws + WS_WIN) + (size_t)2048 * D, MREAL, 2048, D}; pg8::StaticOrder S; S.init(MREAL, 2048, G, bx); \
          pg8::EpiB<P1B_MODE> E{RA, PJ, nullptr, nullptr, 0, 0, 1.f, 0}; \
          pg8::gemm_phase<pg8::EpiB<P1B_MODE>, pg8::StaticOrder, true, true>(lds, g, S, E); \
          thin_gemm<1>(lds, XB, (const bf16*)(ws + WS_WIN) + (size_t)2048 * D, 2048, D, ThinP{RA, PJ, nullptr, nullptr, 0, 0, nullptr, 0.f}); } \
        GSYNC(); \
} while (0)
#define PH_P3A(l) do { \
        if ((l) == 0) { STOP(3, RA, PJ, 1024); } \
        { pg8::Gemm g{RB, (const bf16*)(ws + WS_WA), MREAL, D, D}; pg8::StaticOrder S; S.init(MREAL, D, G, bx); \
          pg8::EpiB<3> E{XB, D, nullptr, RA, PJ, 0, 1.f, 0}; \
          pg8::gemm_phase<pg8::EpiB<3>, pg8::StaticOrder, true, true>(lds, g, S, E); \
          thin_gemm<3>(lds, RB, (const bf16*)(ws + WS_WA), D, D, ThinP{XB, D, nullptr, RA, PJ, 0, nullptr, 0.f}); } \
        GSYNC(); \
} while (0)
#define PH_P3B(l) do { \
        if ((l) == 0) { STOP(4, XB, D, 1024); } \
        { pg8::Gemm g{DBUF, (const bf16*)(ws + WS_WP), MREAL, D, 512}; pg8::StaticOrder S; S.init(MREAL, D, G, bx); \
          pg8::EpiB<4> E{XB, D, nullptr, RA, PJ, 1024, 1.f, 0}; \
          pg8::gemm_phase<pg8::EpiB<4>, pg8::StaticOrder, true, true>(lds, g, S, E); \
          thin_gemm<4>(lds, DBUF, (const bf16*)(ws + WS_WP), D, 512, ThinP{XB, D, nullptr, RA, PJ, 1024, nullptr, 0.f}); } \
        GSYNC(); \
} while (0)
#define PH_P4(l) do { \
        if ((l) == 0) { STOP(5, XB, D, 1024); } \
        { pg8::Gemm g{XB, (const bf16*)(ws + WS_WOUT), MREAL, D, D}; pg8::StaticOrder S; S.init(MREAL, D, G, bx); \
          pg8::EpiRes E{a.out, XFM, MREAL, D, nullptr, ALPHA}; \
          pg8::gemm_phase<pg8::EpiRes, pg8::StaticOrder, true, true>(lds, g, S, E); \
          thin_gemm<5>(lds, XB, (const bf16*)(ws + WS_WOUT), D, D, ThinP{nullptr, 0, nullptr, nullptr, 0, 0, XFM, ALPHA}); } \
        GSYNC(); \
} while (0)
#define PH_P5(l) do { \
        if ((l) == 0) { STOP(6, (const bf16*)nullptr, 0, 1); } \
        ln_rows<4>(a, XFM, XB, a.ln1g + l * D, a.ln1b + l * D, gw, NGW, lane); \
        GSYNC(); \
} while (0)
#define PH_P6(l) do { \
        if ((l) == 0) { STOP(7, XB, D, 1024); } \
        { pg8::Gemm g{XB, (const bf16*)(ws + WS_W1), MREAL, DFF, D}; pg8::StaticOrder S; S.init(MREAL, DFF, G, bx); \
          pg8::EpiB<2> E{RA, DFF, a.b1 + l * DFF, nullptr, 0, 0, 1.f, 0}; \
          pg8::gemm_phase<pg8::EpiB<2>, pg8::StaticOrder, true, true>(lds, g, S, E); \
          thin_gemm<2>(lds, XB, (const bf16*)(ws + WS_W1), DFF, D, ThinP{RA, DFF, a.b1 + l * DFF, nullptr, 0, 0, nullptr, 0.f}); } \
        GSYNC(); \
} while (0)
#define PH_P7(l) do { \
        if ((l) == 0) { STOP(8, RA, DFF, 1024); } \
        { pg8::Gemm g{RA, (const bf16*)(ws + WS_W2), MREAL, D, DFF}; pg8::StaticOrder S; S.init(MREAL, D, G, bx); \
          pg8::EpiRes E{a.out, XFM, MREAL, D, a.b2 + l * D, ALPHA}; \
          pg8::gemm_phase<pg8::EpiRes, pg8::StaticOrder, true, true>(lds, g, S, E); \
          thin_gemm<5>(lds, RA, (const bf16*)(ws + WS_W2), D, DFF, ThinP{nullptr, 0, a.b2 + l * D, nullptr, 0, 0, XFM, ALPHA}); } \
        GSYNC(); \
} while (0)
#define PH_P8(l) do { \
        if ((l) == 0) { STOP(9, (const bf16*)nullptr, 0, 1); } \
        ln_rows<4>(a, XFM, XB, a.ln2g + l * D, a.ln2b + l * D, gw, NGW, lane); \
        if (l + 1 < DEPTH) { convert_weights(a, l + 1, lds, gw, NGW, wave, lane); GSYNC(); } \
} while (0)
#define LAYER_BODY(l) do { PH_P1A(l); X_P1A(l); PH_P2(l); X_P2(l); PH_P1B(l); X_P1B(l); PH_P3A(l); X_P3A(l); PH_P3B(l); X_P3B(l); PH_P4(l); X_P4(l); PH_P5(l); X_P5(l); PH_P6(l); X_P6(l); PH_P7(l); X_P7(l); PH_P8(l); X_P8(l); } while (0)
#ifndef X_P1A
#define X_P1A(l) do {} while (0)
#endif
#ifndef X_P2
#define X_P2(l) do {} while (0)
#endif
#ifndef X_P1B
#define X_P1B(l) do {} while (0)
#endif
#ifndef X_P3A
#define X_P3A(l) do {} while (0)
#endif
#ifndef X_P3B
#define X_P3B(l) do {} while (0)
#endif
#ifndef X_P4
#define X_P4(l) do {} while (0)
#endif
#ifndef X_P5
#define X_P5(l) do {} while (0)
#endif
#ifndef X_P6
#define X_P6(l) do {} while (0)
#endif
#ifndef X_P7
#define X_P7(l) do {} while (0)
#endif
#ifndef X_P8
#define X_P8(l) do {} while (0)
#endif
    LAYER_BODY(0); LAYER_BODY(1); LAYER_BODY(2); LAYER_BODY(3);
}

extern "C" void kernel_launch(void* const* d_in, const int* in_sizes, int n_in, void* d_out, int out_size, void* d_ws, size_t ws_size, hipStream_t stream) {
    static int grid = 0;
    if (grid == 0) {
        if (n_in != 20 || out_size != MREAL * D || ws_size < WS_END) { fprintf(stderr, "kernel_launch: unexpected shapes: n_in %d out %d ws %zu (need %zu)\n", n_in, out_size, ws_size, (size_t)WS_END); grid = -1; return; }
        int dev = 0, cus = 0, per_cu = 0;
        hipGetDevice(&dev); hipDeviceGetAttribute(&cus, hipDeviceAttributeMultiprocessorCount, dev);
        if (hipFuncSetAttribute((const void*)fwd_kernel, hipFuncAttributeMaxDynamicSharedMemorySize, LDS_BYTES) != hipSuccess) { fprintf(stderr, "kernel_launch: hipFuncSetAttribute failed\n"); grid = -1; return; }
        hipOccupancyMaxActiveBlocksPerMultiprocessor(&per_cu, (const void*)fwd_kernel, 512, LDS_BYTES);
        (void)hipGetLastError();
        if (per_cu < 1) fprintf(stderr, "kernel_launch: occupancy query says %d blocks per CU\n", per_cu);
        grid = cus;
    }
    if (grid < 0) return;
    hipMemsetAsync((char*)d_ws + WS_CTL, 0, 1 * MiB, stream);
    Args a{};
    const float** f = (const float**)&a;
    for (int i = 0; i < 20; ++i) f[i] = (const float*)d_in[i];
    a.out = (float*)d_out; a.ws = (unsigned char*)d_ws;
    void* args[] = {&a};
    hipError_t e = hipLaunchCooperativeKernel((const void*)fwd_kernel, dim3(grid), dim3(512), args, LDS_BYTES, stream);
    if (e != hipSuccess) fprintf(stderr, "kernel_launch: cooperative launch failed: %s (grid %d)\n", hipGetErrorString(e), grid);
}
```

```cpp
#define STOP_AFTER 0
#include <hip/hip_runtime.h>
#include <hip/hip_cooperative_groups.h>
#include <cstdio>
#include <cstdint>
#include <cmath>
namespace cg = cooperative_groups;
namespace pg8 {
#define PG8_LAS __attribute__((address_space(3)))
typedef unsigned short bf16_t;
typedef short bf16x8 __attribute__((ext_vector_type(8)));
typedef float f32x4 __attribute__((ext_vector_type(4)));
typedef unsigned u32x4 __attribute__((ext_vector_type(4)));
constexpr int BM = 256, BK = 64, HALF = 128, HTB = HALF * BK * 2  , STAGE_BYTES = 8 * HTB, NXCD = 8, WGM = 8;

__host__ __device__ __forceinline__ int lds_byte(int r, int c) { const int st = (r >> 4) * 2 + (c >> 5), rr = r & 15, cc = c & 31, ob = rr * 64 + cc * 2; return st * 1024 + (ob ^ (((ob >> 9) & 1) << 5)); }
__host__ __device__ __forceinline__ void stage_rc(int b, int& R, int& C) { const int st = b / 1024, sb = b % 1024, swz = sb ^ (((sb >> 9) & 1) << 5); R = (st >> 1) * 16 + swz / 64; C = (st & 1) * 32 + (swz % 64) / 2; }
__host__ __device__ __forceinline__ int perm32(int rho) { const int n = rho >> 4, i = rho & 15; return 8 * (i >> 2) + 4 * n + (i & 3); }

struct Unit { int pm, pn; };
struct Gemm { const bf16_t* A; const bf16_t* Bt; int M, N, K; };

struct StaticOrder {
    int nM, nN, nwg, G, c;
    __host__ __device__ void init(int M, int N, int G_, int c_) { nM = M / BM; nN = N / BM; nwg = nM * nN; G = G_; c = c_; }
    __host__ __device__ bool next(int i, Unit& u) const {
        const long L = (long)i * G + c; if (L >= nwg) return false;
        int wgid = (int)L; { const int q = nwg / NXCD, r = nwg % NXCD, xcd = wgid % NXCD, off = wgid / NXCD; wgid = (xcd < r ? xcd * (q + 1) : r * (q + 1) + (xcd - r) * q) + off; }
        const int nig = WGM * nN, gid = wgid / nig, fm = gid * WGM, gsz = (nM - fm) < WGM ? (nM - fm) : WGM;
        u.pm = fm + ((wgid % nig) % gsz); u.pn = (wgid % nig) / gsz; return true;
    }
    __device__ __forceinline__ void a_ready(const Unit&) const {}
    __device__ __forceinline__ void done(const Unit&) const {}
};

typedef float f32x2_cv __attribute__((ext_vector_type(2))); typedef __bf16 bf16x2_cv __attribute__((ext_vector_type(2)));
__device__ __forceinline__ unsigned cvt_pk_bf16(float lo, float hi) { f32x2_cv v = {lo, hi}; bf16x2_cv b = __builtin_convertvector(v, bf16x2_cv); return __builtin_bit_cast(unsigned, b); }
typedef float f32x2 __attribute__((ext_vector_type(2)));
typedef unsigned u32x4 __attribute__((ext_vector_type(4)));
__device__ __forceinline__ float bf_lo(unsigned w) { return __builtin_bit_cast(float, w << 16); }
__device__ __forceinline__ float bf_hi(unsigned w) { return __builtin_bit_cast(float, w & 0xffff0000u); }
__device__ __forceinline__ u32x4 pack8(f32x4 a, f32x4 b) { u32x4 w; w.x = cvt_pk_bf16(a[0], a[1]); w.y = cvt_pk_bf16(a[2], a[3]); w.z = cvt_pk_bf16(b[0], b[1]); w.w = cvt_pk_bf16(b[2], b[3]); return w; }
__device__ __forceinline__ void unpack8(u32x4 w, f32x4& a, f32x4& b) { a = (f32x4){bf_lo(w.x), bf_hi(w.x), bf_lo(w.y), bf_hi(w.y)}; b = (f32x4){bf_lo(w.z), bf_hi(w.z), bf_lo(w.w), bf_hi(w.w)}; }
__device__ __forceinline__ float sigm(float x) { return __builtin_amdgcn_rcpf(1.0f + __builtin_amdgcn_exp2f(x * -1.4426950408889634f)); }

template <int MODE> struct EpiB {
    static constexpr bool PERM = true, AFTER_DRAIN = false;
    bf16_t* O; int ldc; const float* bias; const bf16_t* G; int ldg; int gcol0; float scale0; int scale_tiles;
    __device__ __forceinline__ void operator()(const f32x4 (&acc)[2][2][4][2], const Unit& u, int wr, int wc, int fr, int fq) const {
        const int row0 = u.pm * BM + wr * 64 + fr; const int col0 = u.pn * BM + wc * 32 + 8 * fq;
        const float sc = (MODE == 0 && u.pn < scale_tiles) ? scale0 : 1.0f;
        f32x4 bv[2][2];
        if (MODE == 2) {
#pragma unroll
            for (int bj = 0; bj < 2; ++bj)
#pragma unroll
                for (int n = 0; n < 2; ++n) bv[bj][n] = *(const f32x4*)(bias + col0 + bj * HALF + 4 * n);
        }
#pragma unroll
        for (int ai = 0; ai < 2; ++ai)
#pragma unroll
            for (int m = 0; m < 4; ++m) { const size_t row = (size_t)(row0 + ai * HALF + m * 16); bf16_t* rowp = O + row * ldc + col0;
#pragma unroll
                for (int bj = 0; bj < 2; ++bj) { f32x4 v0 = acc[ai][bj][m][0], v1 = acc[ai][bj][m][1];
                    if (MODE == 0) { v0 = v0 * sc; v1 = v1 * sc; }
                    if (MODE == 1) { v0 = (f32x4){sigm(v0[0]), sigm(v0[1]), sigm(v0[2]), sigm(v0[3])}; v1 = (f32x4){sigm(v1[0]), sigm(v1[1]), sigm(v1[2]), sigm(v1[3])}; }
                    if (MODE == 2) { v0 = v0 + bv[bj][0]; v1 = v1 + bv[bj][1]; v0 = __builtin_elementwise_max(v0, (f32x4){0.f, 0.f, 0.f, 0.f}); v1 = __builtin_elementwise_max(v1, (f32x4){0.f, 0.f, 0.f, 0.f}); v0 = v0 * v0; v1 = v1 * v1; }
                    if (MODE == 3 || MODE == 4) { const u32x4 gw = *(const u32x4*)(G + row * ldg + gcol0 + col0 + bj * HALF); f32x4 g0, g1; unpack8(gw, g0, g1); v0 = v0 * g0; v1 = v1 * g1; }
                    if (MODE == 4) { const u32x4 ow = *(const u32x4*)(rowp + bj * HALF); f32x4 o0, o1; unpack8(ow, o0, o1); v0 = v0 + o0; v1 = v1 + o1; }
                    *(u32x4*)(rowp + bj * HALF) = pack8(v0, v1); }
                if (MODE >= 3) asm volatile("" ::: "memory"); }
    }
};
struct EpiRes {
    static constexpr bool PERM = false, AFTER_DRAIN = false;
    float* X; float* X2; int split_row; int ldc; const float* bias; float alpha;
    __device__ __forceinline__ void operator()(const f32x4 (&acc)[2][2][4][2], const Unit& u, int wr, int wc, int fr, int fq) const {
        const int col0 = u.pn * BM + wc * 32 + 4 * fq;
        float* base = (u.pm * BM >= split_row) ? X2 + (size_t)(u.pm * BM - split_row) * ldc : X + (size_t)(u.pm * BM) * ldc;
        f32x4 bv[2][2];
#pragma unroll
        for (int bj = 0; bj < 2; ++bj)
#pragma unroll
            for (int n = 0; n < 2; ++n) bv[bj][n] = bias ? *(const f32x4*)(bias + col0 + bj * HALF + n * 16) : (f32x4){0.f, 0.f, 0.f, 0.f};
#pragma unroll
        for (int ai = 0; ai < 2; ++ai)
#pragma unroll
            for (int m = 0; m < 4; ++m) { float* rowp = base + (size_t)(ai * HALF + wr * 64 + m * 16 + fr) * ldc + col0;
#pragma unroll
                for (int bj = 0; bj < 2; ++bj)
#pragma unroll
                    for (int n = 0; n < 2; ++n) { f32x4* p = (f32x4*)(rowp + bj * HALF + n * 16); const f32x4 x = *p; *p = x * alpha + (acc[ai][bj][m][n] + bv[bj][n]); }
                asm volatile("" ::: "memory"); }
    }
};
struct EpiRes2 {
    static constexpr bool PERM = true, AFTER_DRAIN = false;
    float* Y; const bf16_t* Xb; int ldc; const float* bias; float alpha;
    __device__ __forceinline__ void operator()(const f32x4 (&acc)[2][2][4][2], const Unit& u, int wr, int wc, int fr, int fq) const {
        const int row0 = u.pm * BM + wr * 64 + fr; const int col0 = u.pn * BM + wc * 32 + 8 * fq;
        f32x4 bv[2][2];
#pragma unroll
        for (int bj = 0; bj < 2; ++bj)
#pragma unroll
            for (int n = 0; n < 2; ++n) bv[bj][n] = bias ? *(const f32x4*)(bias + col0 + bj * HALF + 4 * n) : (f32x4){0.f, 0.f, 0.f, 0.f};
#pragma unroll
        for (int ai = 0; ai < 2; ++ai)
#pragma unroll
            for (int m = 0; m < 4; ++m) { const size_t off = (size_t)(row0 + ai * HALF + m * 16) * ldc + col0;
#pragma unroll
                for (int bj = 0; bj < 2; ++bj) { const u32x4 xw = *(const u32x4*)(Xb + off + bj * HALF); f32x4 x0, x1; unpack8(xw, x0, x1);
                    *(f32x4*)(Y + off + bj * HALF) = x0 * alpha + (acc[ai][bj][m][0] + bv[bj][0]); *(f32x4*)(Y + off + bj * HALF + 4) = x1 * alpha + (acc[ai][bj][m][1] + bv[bj][1]); }
                asm volatile("" ::: "memory"); }
    }
};

template <class Epi, class Sched, bool ALIGN_EPI = false, bool SP2 = false>
__device__ __forceinline__ void gemm_phase(PG8_LAS unsigned char* lds, const Gemm g, const Sched& S, const Epi& E) {
    int tid_ = threadIdx.x; asm volatile("" : "+v"(tid_));
    const int tid = tid_, wid = __builtin_amdgcn_readfirstlane(tid >> 6), lane = tid & 63, wr = wid >> 2, wc = wid & 3, fr = lane & 15, fq = lane >> 4;
    const int K = g.K, nt = K / BK;
    unsigned voffA[2], voffB[2];
#pragma unroll
    for (int i = 0; i < 2; ++i) { int R, C; stage_rc(tid * 16 + i * 8192, R, C); const int Rb = Epi::PERM ? ((R & ~31) + perm32(R & 31)) : R;
        voffA[i] = (unsigned)(R * K + C) * 2u; voffB[i] = (unsigned)(Rb * K + C) * 2u; }
    const size_t kstep = (size_t)(BK * 2);
    const size_t hstep = (size_t)HALF * K * 2;
    const size_t tstep = 2 * hstep;
    const unsigned ldsw = (unsigned)wid * 1024u;
    const int aoff = lds_byte(wr * 64 + fr, fq * 8), boff = lds_byte(wc * 32 + fr, fq * 8);
#define PG8_SA(b, h) (((b) * 2 + (h)) * HTB)
#define PG8_SB(b, h) ((4 + (b) * 2 + (h)) * HTB)
#define PG8_STAGE(bufoff, gbase, voff) do { _Pragma("unroll") for (int _i = 0; _i < 2; ++_i) \
        __builtin_amdgcn_global_load_lds((const unsigned*)((const char*)(gbase) + (voff)[_i]), (PG8_LAS unsigned*)(lds + (bufoff) + ldsw + _i * 8192), 16, 0, 0); } while (0)
#define PG8_LDA(dst, b, h) do { _Pragma("unroll") for (int m = 0; m < 4; ++m) _Pragma("unroll") for (int k = 0; k < 2; ++k) dst[m][k] = *(const PG8_LAS bf16x8*)(lds + PG8_SA(b, h) + aoff + m * 2048 + k * 1024); } while (0)
#define PG8_LDB(dst, b, h) do { _Pragma("unroll") for (int n = 0; n < 2; ++n) _Pragma("unroll") for (int k = 0; k < 2; ++k) dst[n][k] = *(const PG8_LAS bf16x8*)(lds + PG8_SB(b, h) + boff + n * 2048 + k * 1024); } while (0)
#define PG8_MMA(ai, bj, At, Bt) do { __builtin_amdgcn_s_setprio(1); _Pragma("unroll") for (int m = 0; m < 4; ++m) _Pragma("unroll") for (int n = 0; n < 2; ++n) _Pragma("unroll") for (int k = 0; k < 2; ++k) \
        acc[ai][bj][m][n] = __builtin_amdgcn_mfma_f32_16x16x32_bf16(Bt[n][k], At[m][k], acc[ai][bj][m][n], 0, 0, 0); __builtin_amdgcn_s_setprio(0); } while (0)
#define PG8_WAIT_V(n) asm volatile("s_waitcnt vmcnt(" #n ")" ::: "memory")
#define PG8_WAIT_L(n) asm volatile("s_waitcnt lgkmcnt(" #n ")" ::: "memory")
#define PG8_BAR __builtin_amdgcn_s_barrier()
#define PG8_SCHED __builtin_amdgcn_sched_barrier(0)
    Unit cur, nxt; int ui = 0;
    if (!S.next(0, cur)) return;
    f32x4 acc[2][2][4][2];
#pragma unroll
    for (int a = 0; a < 2; ++a)
#pragma unroll
        for (int b = 0; b < 2; ++b)
#pragma unroll
            for (int m = 0; m < 4; ++m)
#pragma unroll
                for (int n = 0; n < 2; ++n) acc[a][b][m][n] = (f32x4){0.f, 0.f, 0.f, 0.f};
    bf16x8 At[4][2], B0[2][2], B1[2][2];
    const char* cA = (const char*)g.A + (size_t)cur.pm * tstep; const char* cB = (const char*)g.Bt + (size_t)cur.pn * tstep;
    S.a_ready(cur);
    if constexpr (SP2) {
        PG8_STAGE(PG8_SB(0, 0), cB, voffB); PG8_STAGE(PG8_SB(0, 1), cB + hstep, voffB); PG8_STAGE(PG8_SA(0, 0), cA, voffA); PG8_STAGE(PG8_SA(0, 1), cA + hstep, voffA);
        if (wr == 1) PG8_BAR;
        PG8_WAIT_V(2); PG8_BAR;
        PG8_STAGE(PG8_SB(1, 0), cB + kstep, voffB); PG8_STAGE(PG8_SA(1, 0), cA + kstep, voffA); PG8_STAGE(PG8_SB(1, 1), cB + hstep + kstep, voffB);
        PG8_WAIT_V(6); PG8_BAR;
    } else {
        PG8_STAGE(PG8_SB(0, 0), cB, voffB); PG8_STAGE(PG8_SA(0, 0), cA, voffA); PG8_STAGE(PG8_SB(0, 1), cB + hstep, voffB); PG8_STAGE(PG8_SA(0, 1), cA + hstep, voffA);
        if (wr == 1) PG8_BAR;
        PG8_WAIT_V(4); PG8_BAR;
        PG8_STAGE(PG8_SB(1, 0), cB + kstep, voffB); PG8_STAGE(PG8_SA(1, 0), cA + kstep, voffA); PG8_STAGE(PG8_SB(1, 1), cB + hstep + kstep, voffB);
        PG8_WAIT_V(6); PG8_BAR;
    }
    for (;;) {
        const bool has_next = S.next(ui + 1, nxt);
        const char* nA = has_next ? (const char*)g.A + (size_t)nxt.pm * tstep : cA; const char* nB = has_next ? (const char*)g.Bt + (size_t)nxt.pn * tstep : cB;
        for (int t = 0; t < nt; t += 2) {
            const bool last = (t == nt - 2);
            const char* a1 = cA + (size_t)(t + 1) * kstep;
            const char* a2 = last ? nA : cA + (size_t)(t + 2) * kstep; const char* b2 = last ? nB : cB + (size_t)(t + 2) * kstep;
            const char* a3 = a2 + kstep; const char* b3 = b2 + kstep;
            if (last && has_next) S.a_ready(nxt);
            if constexpr (SP2) {
            PG8_LDB(B0, 0, 0); PG8_LDB(B1, 0, 1); PG8_SCHED; PG8_LDA(At, 0, 0); PG8_STAGE(PG8_SA(1, 1), a1 + hstep, voffA);
            PG8_WAIT_V(8); PG8_WAIT_L(0); PG8_BAR; PG8_MMA(0, 0, At, B0); PG8_MMA(0, 1, At, B1); PG8_BAR; PG8_SCHED;
            PG8_LDA(At, 0, 1); PG8_STAGE(PG8_SB(0, 0), b2, voffB); PG8_STAGE(PG8_SB(0, 1), b2 + hstep, voffB); PG8_STAGE(PG8_SA(0, 0), a2, voffA);
            PG8_WAIT_V(8); PG8_WAIT_L(0); PG8_BAR; PG8_MMA(1, 0, At, B0); PG8_MMA(1, 1, At, B1); PG8_BAR; PG8_SCHED;
            PG8_LDB(B0, 1, 0); PG8_LDB(B1, 1, 1); PG8_SCHED; PG8_LDA(At, 1, 0); PG8_STAGE(PG8_SA(0, 1), a2 + hstep, voffA);
            PG8_WAIT_V(8); PG8_WAIT_L(0); PG8_BAR; PG8_MMA(0, 0, At, B0); PG8_MMA(0, 1, At, B1); PG8_BAR; PG8_SCHED;
            PG8_LDA(At, 1, 1); PG8_STAGE(PG8_SB(1, 0), b3, voffB); PG8_STAGE(PG8_SB(1, 1), b3 + hstep, voffB); PG8_STAGE(PG8_SA(1, 0), a3, voffA);
            PG8_WAIT_V(8); PG8_WAIT_L(0); PG8_BAR; PG8_MMA(1, 0, At, B0); PG8_MMA(1, 1, At, B1); PG8_BAR; PG8_SCHED;
            } else {
            PG8_LDB(B0, 0, 0); PG8_SCHED; PG8_LDA(At, 0, 0); PG8_STAGE(PG8_SA(1, 1), a1 + hstep, voffA);
            PG8_WAIT_L(8); PG8_BAR; PG8_WAIT_L(0); PG8_MMA(0, 0, At, B0); PG8_BAR; PG8_SCHED;
            PG8_LDB(B1, 0, 1); PG8_STAGE(PG8_SB(0, 0), b2, voffB);
            PG8_BAR; PG8_WAIT_L(0); PG8_MMA(0, 1, At, B1); PG8_BAR;
            PG8_LDA(At, 0, 1); PG8_STAGE(PG8_SA(0, 0), a2, voffA);
            PG8_BAR; PG8_WAIT_L(0); PG8_MMA(1, 0, At, B0); PG8_BAR; PG8_SCHED;
            PG8_STAGE(PG8_SB(0, 1), b2 + hstep, voffB);
            PG8_WAIT_V(6); PG8_BAR; PG8_MMA(1, 1, At, B1); PG8_BAR;
            PG8_LDB(B0, 1, 0); PG8_SCHED; PG8_LDA(At, 1, 0); PG8_STAGE(PG8_SA(0, 1), a2 + hstep, voffA);
            PG8_WAIT_L(8); PG8_BAR; PG8_WAIT_L(0); PG8_MMA(0, 0, At, B0); PG8_BAR; PG8_SCHED;
            PG8_LDB(B1, 1, 1); PG8_STAGE(PG8_SB(1, 0), b3, voffB);
            PG8_BAR; PG8_WAIT_L(0); PG8_MMA(0, 1, At, B1); PG8_BAR;
            PG8_LDA(At, 1, 1); PG8_STAGE(PG8_SA(1, 0), a3, voffA);
            PG8_BAR; PG8_WAIT_L(0); PG8_MMA(1, 0, At, B0); PG8_BAR; PG8_SCHED;
            PG8_STAGE(PG8_SB(1, 1), b3 + hstep, voffB);
            PG8_WAIT_V(6); PG8_BAR; PG8_MMA(1, 1, At, B1); PG8_BAR;
            }
        }
        if constexpr (ALIGN_EPI) { if (wr == 0) PG8_BAR; }
        if constexpr (!Epi::AFTER_DRAIN) { E(acc, cur, wr, wc, fr, fq); S.done(cur); }
        if (!has_next) break;
#pragma unroll
        for (int a = 0; a < 2; ++a)
#pragma unroll
            for (int b = 0; b < 2; ++b)
#pragma unroll
                for (int m = 0; m < 4; ++m)
#pragma unroll
                    for (int n = 0; n < 2; ++n) acc[a][b][m][n] = (f32x4){0.f, 0.f, 0.f, 0.f};
        cur = nxt; cA = nA; cB = nB; ++ui;
        if constexpr (ALIGN_EPI) { if (wr == 1) PG8_BAR; }
    }
    PG8_WAIT_V(0);
    if constexpr (!ALIGN_EPI) { if (wr == 0) PG8_BAR; }
    PG8_BAR;
    if constexpr (Epi::AFTER_DRAIN) { E.fused(acc, cur, wr, wc, fr, fq, lds, wid, lane); S.done(cur); }
#undef PG8_SA
#undef PG8_SB
#undef PG8_STAGE
#undef PG8_LDA
#undef PG8_LDB
#undef PG8_MMA
#undef PG8_WAIT_V
#undef PG8_WAIT_L
#undef PG8_BAR
#undef PG8_SCHED
}
}
#define GAS __attribute__((address_space(1)))
#define LAS __attribute__((address_space(3)))
typedef unsigned short bf16;
typedef unsigned v4u __attribute__((ext_vector_type(4)));
typedef float f32x4 __attribute__((ext_vector_type(4)));
typedef short bf16x8 __attribute__((ext_vector_type(8)));
typedef GAS unsigned gu32;
typedef GAS unsigned long long gu64;
#define RLX_AGENT __ATOMIC_RELAXED, __HIP_MEMORY_SCOPE_AGENT
#define LDS_WAIT() asm volatile("s_waitcnt lgkmcnt(0)" ::: "memory")
#define VM_WAIT() asm volatile("s_waitcnt vmcnt(0)" ::: "memory")
__device__ __forceinline__ unsigned long long rt() { return __builtin_amdgcn_s_memrealtime(); }
__device__ __forceinline__ unsigned f2bf(float f) { unsigned u = __builtin_bit_cast(unsigned, f); return (u + 0x7fffu + ((u >> 16) & 1u)) >> 16; }
__device__ __forceinline__ unsigned pk2(float lo, float hi) { return f2bf(lo) | (f2bf(hi) << 16); }

#define XB_TMO      128
#define XB_XCNT(j)  (256  + 64 * (j))
#define XB_XSUB(j)  (1280 + 64 * (j))
#define XB_XGEN(j)  (2304 + 64 * (j))
#define XB_TOP      3328
#define XB_TOPGEN   3392
#define XCD_BAR_WORDS 3456
#define XB_SPIN_CAP (1u << 18)

__device__ __forceinline__ unsigned xb_ld(unsigned* p)              { return __hip_atomic_load(p, __ATOMIC_RELAXED, __HIP_MEMORY_SCOPE_AGENT); }
__device__ __forceinline__ unsigned xb_add(unsigned* p, unsigned v) { return __hip_atomic_fetch_add(p, v, __ATOMIC_RELAXED, __HIP_MEMORY_SCOPE_AGENT); }
__device__ __forceinline__ unsigned xb_xcc_id() { return (unsigned)__builtin_amdgcn_s_getreg((3 << 11) | 20) & 0xFu; }
#define XB_SPIN(cond, bar) do { unsigned _sp = 0; while (cond) { __builtin_amdgcn_s_sleep(1); \
    if ((++_sp & 255u) == 0u) { if (xb_ld(&(bar)[XB_TMO])) break; if (_sp > XB_SPIN_CAP) { atomicAdd(&(bar)[XB_TMO], 1u); break; } } } } while (0)

struct XcdBarrier {
    unsigned* bar; unsigned x;
    volatile LAS unsigned* st;
};

__device__ __forceinline__ XcdBarrier xcd_barrier_post(unsigned* bar, volatile LAS unsigned* st) {
    XcdBarrier b; b.bar = bar; b.x = xb_xcc_id(); b.st = st;
    if (threadIdx.x == 0) (void)xb_add(&bar[XB_XCNT(b.x)], 1u);
    return b;
}
__device__ __forceinline__ void xcd_barrier_complete(unsigned* bar, unsigned x, unsigned& nloc, unsigned& nx) {
    const unsigned G = gridDim.x * gridDim.y * gridDim.z;
    unsigned sum, cnt, mine, sp = 0u;
    for (;;) {
        sum = 0u; cnt = 0u; mine = 0u;
#pragma unroll
        for (unsigned j = 0; j < 16; ++j) { const unsigned c = xb_ld(&bar[XB_XCNT(j)]); sum += c; cnt += (c > 0u) ? 1u : 0u; mine = (j == x) ? c : mine; }
        if (sum == G) break;
        __builtin_amdgcn_s_sleep(1);
        if ((++sp & 255u) == 0u) { if (xb_ld(&bar[XB_TMO])) break; if (sp > XB_SPIN_CAP) { atomicAdd(&bar[XB_TMO], 1u); break; } }
    }
    nloc = mine > 0u ? mine : 1u; nx = cnt > 0u ? cnt : 1u;
}

__device__ __forceinline__ void xcd_barrier(const XcdBarrier& b) {
    asm volatile("s_waitcnt vmcnt(0)" ::: "memory");
    __syncthreads();
    if (threadIdx.x == 0) {
        unsigned* bar = b.bar;
        __builtin_amdgcn_s_waitcnt(0);
        unsigned nloc = b.st[0], nx = b.st[1];
        if (nloc == 0u) { xcd_barrier_complete(bar, b.x, nloc, nx); b.st[0] = nloc; b.st[1] = nx; }
        const unsigned old = xb_add(&bar[XB_XSUB(b.x)], 1u);
        const unsigned gen = old / nloc;
        if (old + 1u == (gen + 1u) * nloc) {
            __builtin_amdgcn_fence(__ATOMIC_RELEASE, "agent");
            asm volatile("s_waitcnt vmcnt(0)" ::: "memory");
            const unsigned og = xb_add(&bar[XB_TOP], 1u);
            const unsigned tg = og / nx;
            if (og + 1u == (tg + 1u) * nx) xb_add(&bar[XB_TOPGEN], 1u);
            else XB_SPIN(xb_ld(&bar[XB_TOPGEN]) == tg, bar);
            __builtin_amdgcn_fence(__ATOMIC_ACQUIRE, "agent");
            xb_add(&bar[XB_XGEN(b.x)], 1u);
            asm volatile("s_waitcnt vmcnt(0)" ::: "memory");
        } else {
            XB_SPIN(xb_ld(&bar[XB_XGEN(b.x)]) == gen, bar);
            __builtin_amdgcn_fence(__ATOMIC_ACQUIRE, "agent");
            asm volatile("s_waitcnt vmcnt(0)" ::: "memory");
        }
    }
    __syncthreads();
}

constexpr int D = 1024, DEPTH = 4, NSEQ = 6, NMETA = 16, DFF = 4096, INW = 4096;
constexpr int MREAL = 32768, MROWS = MREAL + NSEQ * NMETA  , MP = 33024  ;
constexpr float LN_EPS = 1e-5f;
constexpr float ALPHA = 1.6817928305074290f;
constexpr float LOG2E = 1.4426950408889634f;
constexpr float QSCALE = 0.125f * LOG2E;
constexpr int PJ = 2048, PJ_K = 1024, PJ_V = 1280, PJ_U = 1536;

constexpr size_t MiB = 1u << 20;
constexpr size_t WS_CTL = 0;
constexpr size_t WS_WIN = 1 * MiB, WS_WA = 9 * MiB, WS_WP = 11 * MiB, WS_WOUT = 12 * MiB, WS_W1 = 14 * MiB, WS_W2 = 22 * MiB;
constexpr size_t WS_XFM = 30 * MiB;
constexpr size_t WS_XB = 31 * MiB;
constexpr size_t SZ_XB = (size_t)MP * 1024 * 2;
constexpr size_t WS_A = WS_XB + SZ_XB;
constexpr size_t SZ_A = (size_t)MP * 2048 * 2;
constexpr size_t WS_B = WS_A + SZ_A;
constexpr size_t WS_END = WS_B + SZ_A;
constexpr int LDS_BYTES = 147456;

struct Args {
    const float *xp, *xs, *meta, *lneg, *lneb, *win, *sink, *wpool, *pscale, *wba, *wbp, *wout, *ln1g, *ln1b, *w1, *b1, *w2, *b2, *ln2g, *ln2b;
    float* out; unsigned char* ws;
};

__device__ __forceinline__ float wave_sum(float v) {
#pragma unroll
    for (int o = 1; o < 64; o <<= 1) v += __shfl_xor(v, o);
    return v;
}
__device__ __forceinline__ unsigned cvtpk(float lo, float hi) { return pg8::cvt_pk_bf16(lo, hi); }

__device__ __forceinline__ void transpose_item(const float* __restrict__ W, int K, int N, bf16* __restrict__ WT, LAS float* scr, int item, int lane) {
    const int nblk = N / 32, kb = item / nblk, nb = item % nblk, k0 = 64 * kb, n0 = 32 * nb;
    float wv[32];
#pragma unroll
    for (int i = 0; i < 32; ++i) wv[i] = W[(size_t)(k0 + 2 * i + (lane >> 5)) * N + n0 + (lane & 31)];
#pragma unroll
    for (int i = 0; i < 32; ++i) scr[(2 * i + (lane >> 5)) * 33 + (lane & 31)] = wv[i];
    LDS_WAIT(); asm volatile("" ::: "memory");
    const int c = lane & 7;
#pragma unroll
    for (int j = 0; j < 4; ++j) { const int n = (lane >> 3) + 8 * j; const LAS float* s = scr + (8 * c) * 33 + n;
        v4u o; o.x = cvtpk(s[0 * 33], s[1 * 33]); o.y = cvtpk(s[2 * 33], s[3 * 33]); o.z = cvtpk(s[4 * 33], s[5 * 33]); o.w = cvtpk(s[6 * 33], s[7 * 33]);
        *(v4u*)(WT + (size_t)(n0 + n) * K + k0 + 8 * c) = o; }
    LDS_WAIT(); asm volatile("" ::: "memory");
}

__device__ __forceinline__ void convert_weights(const Args& a, int l, LAS unsigned char* lds, int gw, int NGW, int wave, int lane) {
    unsigned char* ws = a.ws;
    LAS float* scr = (LAS float*)(lds + wave * 16384);
    constexpr int I_IN = (D / 64) * (INW / 32), I_SQ = (D / 64) * (D / 32), I_1 = (D / 64) * (DFF / 32), I_2 = (DFF / 64) * (D / 32);
    constexpr int NIT = I_IN + 2 * I_SQ + I_1 + I_2;
    for (int it = gw; it < NIT; it += NGW) {
        int r = it;
        if (r < I_IN) { transpose_item(a.win + (size_t)l * D * INW, D, INW, (bf16*)(ws + WS_WIN), scr, r, lane); continue; } r -= I_IN;
        if (r < I_SQ) { transpose_item(a.wba + (size_t)l * D * D, D, D, (bf16*)(ws + WS_WA), scr, r, lane); continue; } r -= I_SQ;
        if (r < I_SQ) { transpose_item(a.wout + (size_t)l * D * D, D, D, (bf16*)(ws + WS_WOUT), scr, r, lane); continue; } r -= I_SQ;
        if (r < I_1) { transpose_item(a.w1 + (size_t)l * D * DFF, D, DFF, (bf16*)(ws + WS_W1), scr, r, lane); continue; } r -= I_1;
        transpose_item(a.w2 + (size_t)l * DFF * D, DFF, D, (bf16*)(ws + WS_W2), scr, r, lane);
    }
    const float* wpool = a.wpool + (size_t)l * 4 * 128 * 128; const float* ps = a.pscale + (size_t)l * 512; const float* wbp = a.wbp + (size_t)l * 512 * D;
    bf16* WPT = (bf16*)(ws + WS_WP);
    for (int it = gw; it < 1024; it += NGW) {
        const int cch = it >> 4, n = ((it & 15) << 6) + lane; const int g = cch >> 4, c0 = (cch & 15) * 8;
        float acc[8];
#pragma unroll
        for (int e = 0; e < 8; ++e) acc[e] = 0.f;
        const float* wp = wpool + (size_t)(g * 128 + c0) * 128;
#pragma unroll 16
        for (int j = 0; j < 128; ++j) {
            const float w = ps[g * 128 + j] * wbp[(size_t)(g * 128 + j) * D + n];
#pragma unroll
            for (int e = 0; e < 8; ++e) acc[e] += wp[e * 128 + j] * w;
        }
        v4u o; o.x = cvtpk(acc[0], acc[1]); o.y = cvtpk(acc[2], acc[3]); o.z = cvtpk(acc[4], acc[5]); o.w = cvtpk(acc[6], acc[7]);
        *(v4u*)(WPT + (size_t)n * 512 + g * 128 + c0) = o;
    }
}

__device__ __forceinline__ void ln_row(const float* src, float* dstF, bf16* dstB, const float* __restrict__ g, const float* __restrict__ b, int lane) {
    const f32x4* xr = (const f32x4*)src + lane;
    f32x4 v[4]; float s = 0.f;
#pragma unroll
    for (int j = 0; j < 4; ++j) { v[j] = xr[64 * j]; s += (v[j].x + v[j].y) + (v[j].z + v[j].w); }
    const float mean = wave_sum(s) * (1.f / D); float s2 = 0.f;
#pragma unroll
    for (int j = 0; j < 4; ++j) { v[j] = v[j] - mean; s2 += (v[j].x * v[j].x + v[j].y * v[j].y) + (v[j].z * v[j].z + v[j].w * v[j].w); }
    const float rstd = 1.f / sqrtf(wave_sum(s2) * (1.f / D) + LN_EPS);
#pragma unroll
    for (int j = 0; j < 4; ++j) {
        const f32x4 gg = ((const f32x4*)g)[lane + 64 * j], bb = ((const f32x4*)b)[lane + 64 * j];
        const f32x4 y = v[j] * rstd * gg + bb;
        if (dstF) ((f32x4*)dstF)[lane + 64 * j] = y;
        typedef unsigned u32x2v __attribute__((ext_vector_type(2)));
        u32x2v w; w.x = cvtpk(y.x, y.y); w.y = cvtpk(y.z, y.w);
        ((u32x2v*)dstB)[lane + 64 * j] = w;
    }
}


template <int NB, bool FINAL> __device__ __forceinline__ void ln_rows(const float* srcA, const float* srcM, bf16* XB, const float* __restrict__ g, const float* __restrict__ b, int gw, int NGW, int lane) {
    const int nrows = FINAL ? MREAL : MROWS;
    for (int r0 = gw; r0 < nrows; r0 += NB * NGW) {
        f32x4 v[NB][4]; const float* rp[NB]; bool ok[NB];
#pragma unroll
        for (int i = 0; i < NB; ++i) { const int r = r0 + i * NGW; ok[i] = r < nrows; const int rc = ok[i] ? r : r0; rp[i] = rc < MREAL ? srcA + (size_t)rc * D : srcM + (size_t)(rc - MREAL) * D;
#pragma unroll
            for (int j = 0; j < 4; ++j) v[i][j] = ((const f32x4*)rp[i])[lane + 64 * j]; }
#pragma unroll
        for (int i = 0; i < NB; ++i) {
            float s = 0.f;
#pragma unroll
            for (int j = 0; j < 4; ++j) s += (v[i][j].x + v[i][j].y) + (v[i][j].z + v[i][j].w);
            const float mean = wave_sum(s) * (1.f / D); float s2 = 0.f;
#pragma unroll
            for (int j = 0; j < 4; ++j) { v[i][j] = v[i][j] - mean; s2 += (v[i][j].x * v[i][j].x + v[i][j].y * v[i][j].y) + (v[i][j].z * v[i][j].z + v[i][j].w * v[i][j].w); }
            const float rstd = 1.f / sqrtf(wave_sum(s2) * (1.f / D) + LN_EPS);
            if (ok[i]) {
                const int r = r0 + i * NGW;
#pragma unroll
                for (int j = 0; j < 4; ++j) {
                    const f32x4 gg = ((const f32x4*)g)[lane + 64 * j], bb = ((const f32x4*)b)[lane + 64 * j];
                    const f32x4 y = v[i][j] * rstd * gg + bb;
                    if (FINAL) ((f32x4*)const_cast<float*>(rp[i]))[lane + 64 * j] = y;
                    else { typedef unsigned u32x2v __attribute__((ext_vector_type(2))); u32x2v w; w.x = cvtpk(y.x, y.y); w.y = cvtpk(y.z, y.w); ((u32x2v*)(XB + (size_t)r * D))[lane + 64 * j] = w; }
                }
            }
        }
    }
}

struct ThinP { bf16* O; int ldc; const float* bias; const bf16* G; int ldg; int gcol0; float* XF; float alpha; };
template <int MODE> __device__ __forceinline__ void thin_epi(const ThinP& P, int row, int col, f32x4 v) {
    typedef unsigned u32x2v __attribute__((ext_vector_type(2)));
    if (MODE == 5) { typedef unsigned u32x2w __attribute__((ext_vector_type(2))); const u32x2w xw = *(const u32x2w*)(P.G + (size_t)row * P.ldg + col); const f32x4 x = {pg8::bf_lo(xw.x), pg8::bf_hi(xw.x), pg8::bf_lo(xw.y), pg8::bf_hi(xw.y)};
        const f32x4 bv = P.bias ? *(const f32x4*)(P.bias + col) : (f32x4){0.f, 0.f, 0.f, 0.f}; *(f32x4*)(P.XF + (size_t)(row - MREAL) * D + col) = x * P.alpha + (v + bv); return; }
    if (MODE == 0) { if (col < 1024) v = v * QSCALE; }
    if (MODE == 1) { v = (f32x4){pg8::sigm(v[0]), pg8::sigm(v[1]), pg8::sigm(v[2]), pg8::sigm(v[3])}; }
    if (MODE == 2) { v = v + *(const f32x4*)(P.bias + col); v = __builtin_elementwise_max(v, (f32x4){0.f, 0.f, 0.f, 0.f}); v = v * v; }
    bf16* op = P.O + (size_t)row * P.ldc + col;
    if (MODE == 3 || MODE == 4) { const u32x2v gw = *(const u32x2v*)(P.G + (size_t)row * P.ldg + P.gcol0 + col); v = v * (f32x4){pg8::bf_lo(gw.x), pg8::bf_hi(gw.x), pg8::bf_lo(gw.y), pg8::bf_hi(gw.y)}; }
    if (MODE == 4) { const u32x2v ow = *(const u32x2v*)op; v = v + (f32x4){pg8::bf_lo(ow.x), pg8::bf_hi(ow.x), pg8::bf_lo(ow.y), pg8::bf_hi(ow.y)}; }
    u32x2v w; w.x = cvtpk(v[0], v[1]); w.y = cvtpk(v[2], v[3]); *(u32x2v*)op = w;
}
template <int MODE> __device__ __forceinline__ void thin_gemm(LAS unsigned char* lds, const bf16* A, const bf16* Bt, int N, int K, const ThinP P) {
    int tid_ = threadIdx.x; asm volatile("" : "+v"(tid_));
    const int lane = tid_ & 63, wid = __builtin_amdgcn_readfirstlane(tid_ >> 6), fr = lane & 15, fq = lane >> 4;
    const int nct = N / 16, ks = K / 8, nst = ks / 32;
    LAS f32x4* red = (LAS f32x4*)lds;
    for (int ct = blockIdx.x; ct < nct; ct += gridDim.x) {
        f32x4 acc[6];
#pragma unroll
        for (int rt = 0; rt < 6; ++rt) acc[rt] = (f32x4){0.f, 0.f, 0.f, 0.f};
        const bf16* bp = Bt + (size_t)(ct * 16 + fr) * K + wid * ks + 8 * fq;
        const bf16* ap = A + (size_t)(MREAL + fr) * K + wid * ks + 8 * fq;
#pragma unroll 4
        for (int s = 0; s < nst; ++s) {
            const bf16x8 b = *(const bf16x8*)(bp + 32 * s);
            bf16x8 av[6];
#pragma unroll
            for (int rt = 0; rt < 6; ++rt) av[rt] = *(const bf16x8*)(ap + (size_t)rt * 16 * K + 32 * s);
#pragma unroll
            for (int rt = 0; rt < 6; ++rt) acc[rt] = __builtin_amdgcn_mfma_f32_16x16x32_bf16(b, av[rt], acc[rt], 0, 0, 0);
        }
#pragma unroll
        for (int rt = 0; rt < 6; ++rt) red[(wid * 6 + rt) * 64 + lane] = acc[rt];
        __syncthreads();
        if (wid < 6) {
            f32x4 v = red[wid * 64 + lane];
#pragma unroll
            for (int w = 1; w < 8; ++w) v += red[(w * 6 + wid) * 64 + lane];
            thin_epi<MODE>(P, MREAL + wid * 16 + fr, ct * 16 + 4 * fq, v);
        }
        __syncthreads();
    }
}

typedef float f32x16 __attribute__((ext_vector_type(16)));
typedef short s16x4 __attribute__((ext_vector_type(4)));
constexpr int AT_KROWS = 416, AT_ROWB = 128, AT_LDS_V = AT_KROWS * AT_ROWB;
__device__ __forceinline__ int at_koff(int row, int c) { return row * AT_ROWB + ((c ^ ((row >> 1) & 7)) << 4); }
__device__ __forceinline__ int at_voff(int row, int c) { return row * AT_ROWB + ((c ^ (((row >> 1) & 1) << 2)) << 4); }
__device__ __forceinline__ float half_max(float m) { auto rr = __builtin_amdgcn_permlane32_swap(__float_as_uint(m), __float_as_uint(m), false, false); return __builtin_fmaxf(__uint_as_float(rr[0]), __uint_as_float(rr[1])); }
__device__ __forceinline__ float half_sum(float m) { auto rr = __builtin_amdgcn_permlane32_swap(__float_as_uint(m), __float_as_uint(m), false, false); return __uint_as_float(rr[0]) + __uint_as_float(rr[1]); }
__device__ __forceinline__ s16x4 vtr(const LAS unsigned char* p) { typedef short v4i16_t __attribute__((ext_vector_type(4))); return __builtin_bit_cast(s16x4, __builtin_amdgcn_ds_read_tr16_b64_v4i16((LAS v4i16_t*)p)); }


template <int HALF> __device__ __forceinline__ void pool_items(const bf16* __restrict__ PROJ, bf16* __restrict__ DB, int kh, int p0, int nrows, int mb, int rb, int L, int tid) {
    constexpr int NW = 4 + 2 * HALF;
    for (int it = tid; it < (nrows >> 2) * 16; it += 512) {
        const int c = it & 15, pb = p0 + 4 * (it >> 4) - HALF;
        const bf16* ucol = PROJ + PJ_U + 128 * kh + 8 * c;
        v4u rw[NW];
#pragma unroll
        for (int j = 0; j < NW; ++j) { const int pos = pb + j; const bool valid = pos >= 0 && pos < L; const int pc = pos < 0 ? 0 : (pos >= L ? L - 1 : pos); const int row = pc < 16 ? mb + pc : rb + pc - 16;
            v4u w = *(const v4u*)(ucol + (size_t)row * PJ); if (!valid) w = (v4u){0u, 0u, 0u, 0u}; rw[j] = w; }
        f32x4 s0 = {0.f, 0.f, 0.f, 0.f}, s1 = {0.f, 0.f, 0.f, 0.f};
#pragma unroll
        for (int j = 0; j < 2 * HALF; ++j) { f32x4 x0, x1; pg8::unpack8(rw[j], x0, x1); s0 += x0; s1 += x1; }
#pragma unroll
        for (int r = 0; r < 4; ++r) {
            const int p = pb + HALF + r; const int lo = p - HALF < 0 ? 0 : p - HALF, hi_ = p + HALF > L ? L : p + HALF;
            const float inv = 1.0f / (float)(hi_ - lo);
            f32x4 c0, c1; pg8::unpack8(rw[HALF + r], c0, c1);
            const int prow = p < 16 ? mb + p : rb + p - 16;
            *(v4u*)(DB + (size_t)prow * 512 + 128 * kh + 8 * c) = pg8::pack8(s0 * inv - c0, s1 * inv - c1);
            if (r < 3) { f32x4 a0, a1, b0, b1; pg8::unpack8(rw[2 * HALF + r], a0, a1); pg8::unpack8(rw[r], b0, b1); s0 += a0 - b0; s1 += a1 - b1; }
        }
    }
}


constexpr int AT_RK = 0, AT_RV = 65536, AT_MK = 131072, AT_MV = 135168, AT_CTL = 139264;
__device__ __forceinline__ int sw_k(int r, int c) { return r * AT_ROWB + ((c ^ ((r >> 1) & 7)) << 4); }
__device__ __forceinline__ int sw_v(int r, int c) { return r * AT_ROWB + ((c ^ (((r >> 1) & 1) << 2)) << 4); }
__device__ __forceinline__ int ring_row(int key) { return (((key >> 7) & 3) << 7) + (key & 127); }

__device__ __forceinline__ void at_softmax(f32x16& p, float& m, float& l, f32x16& o0, f32x16& o1, float basef, float nsl, bool bias, bool mask, bool meta16) {
    if (bias) {
#pragma unroll
        for (int r = 0; r < 16; ++r) { const float t = basef + (float)((r & 3) + 8 * (r >> 2)); float sc = p[r] + nsl * __builtin_fabsf(t); if (mask && __builtin_fabsf(t) > 128.0f) sc = -INFINITY; p[r] = sc; }
    }
    if (meta16) {
#pragma unroll
        for (int r = 8; r < 16; ++r) p[r] = -INFINITY;
    }
    float mx = p[0];
#pragma unroll
    for (int r = 1; r < 16; ++r) mx = __builtin_fmaxf(mx, p[r]);
    mx = half_max(mx);
    if (__builtin_amdgcn_ballot_w64(mx > m + 8.0f) != 0ull) {
        const float mn = __builtin_fmaxf(m, mx), al = __builtin_amdgcn_exp2f(m - mn); m = mn; l *= al;
#pragma unroll
        for (int r = 0; r < 16; ++r) { o0[r] *= al; o1[r] *= al; }
    }
    float sum = 0.f;
#pragma unroll
    for (int r = 0; r < 16; ++r) { p[r] = __builtin_amdgcn_exp2f(p[r] - m); sum += p[r]; }
    l += sum;
}
__device__ __forceinline__ bf16x8 at_pack(const f32x16& p, int st) { v4u pw; pw.x = cvtpk(p[8 * st + 0], p[8 * st + 1]); pw.y = cvtpk(p[8 * st + 2], p[8 * st + 3]); pw.z = cvtpk(p[8 * st + 4], p[8 * st + 5]); pw.w = cvtpk(p[8 * st + 6], p[8 * st + 7]); return __builtin_bit_cast(bf16x8, pw); }
__device__ __forceinline__ void at_store(bf16* AO, int qrow, int h, int hi, const f32x16& o0, const f32x16& o1, float inv) {
    bf16* orow = AO + (size_t)qrow * D + h * 64 + 4 * hi;
    typedef unsigned u32x2v __attribute__((ext_vector_type(2)));
#pragma unroll
    for (int a4 = 0; a4 < 4; ++a4) {
        u32x2v w0; w0.x = cvtpk(o0[4 * a4] * inv, o0[4 * a4 + 1] * inv); w0.y = cvtpk(o0[4 * a4 + 2] * inv, o0[4 * a4 + 3] * inv);
        u32x2v w1; w1.x = cvtpk(o1[4 * a4] * inv, o1[4 * a4 + 1] * inv); w1.y = cvtpk(o1[4 * a4 + 2] * inv, o1[4 * a4 + 3] * inv);
        *(u32x2v*)(orow + 8 * a4) = w0; *(u32x2v*)(orow + 32 + 8 * a4) = w1;
    }
}
__device__ __forceinline__ void attn_wave(LAS unsigned char* lds, const bf16* __restrict__ PROJ, bf16* __restrict__ AO, int rb, int mb, int kend, int h, float nsl, float sinkl, int q0, int nsub, int lane) {
    const int l31 = lane & 31, hi = lane >> 5, L15 = lane & 15, g4 = (lane >> 4) & 1;
    const int qposA = q0 + l31, qposB = (nsub == 2) ? q0 + 32 + l31 : qposA;
    const int qrowA = qposA >= 0 ? rb + qposA : mb + 16 + qposA, qrowB = qposB >= 0 ? rb + qposB : mb + 16 + qposB;
    bf16x8 qa[4], qb[4];
#pragma unroll
    for (int d0 = 0; d0 < 4; ++d0) { qa[d0] = *(const bf16x8*)(PROJ + (size_t)qrowA * PJ + h * 64 + d0 * 16 + hi * 8); qb[d0] = *(const bf16x8*)(PROJ + (size_t)qrowB * PJ + h * 64 + d0 * 16 + hi * 8); }
    float mA = sinkl, mB = sinkl, lA = (hi == 0) ? 1.0f : 0.0f, lB = lA;
    f32x16 oA0 = {}, oA1 = {}, oB0 = {}, oB1 = {};
    const int vr = 4 * hi + (L15 >> 2), vc = 2 * g4 + ((L15 & 3) >> 1), vb = (L15 & 1) * 8;
    const bool two = nsub == 2;
    {
        f32x16 pA = {}, pB = {};
#pragma unroll
        for (int d0 = 0; d0 < 4; ++d0) { const bf16x8 kf = *(const LAS bf16x8*)(lds + AT_MK + sw_k(l31, 2 * d0 + hi)); pA = __builtin_amdgcn_mfma_f32_32x32x16_bf16(kf, qa[d0], pA, 0, 0, 0); if (two) pB = __builtin_amdgcn_mfma_f32_32x32x16_bf16(kf, qb[d0], pB, 0, 0, 0); }
        at_softmax(pA, mA, lA, oA0, oA1, 0.f, 0.f, false, false, true);
        if (two) at_softmax(pB, mB, lB, oB0, oB1, 0.f, 0.f, false, false, true);
        const bf16x8 pfA = at_pack(pA, 0), pfB = at_pack(pB, 0);
#pragma unroll
        for (int dt = 0; dt < 2; ++dt) {
            const s16x4 lo = vtr(lds + AT_MV + sw_v(vr, 4 * dt + vc) + vb), hh = vtr(lds + AT_MV + sw_v(vr + 8, 4 * dt + vc) + vb);
            const bf16x8 vf = (bf16x8){lo[0], lo[1], lo[2], lo[3], hh[0], hh[1], hh[2], hh[3]};
            if (dt == 0) { oA0 = __builtin_amdgcn_mfma_f32_32x32x16_bf16(vf, pfA, oA0, 0, 0, 0); if (two) oB0 = __builtin_amdgcn_mfma_f32_32x32x16_bf16(vf, pfB, oB0, 0, 0, 0); }
            else { oA1 = __builtin_amdgcn_mfma_f32_32x32x16_bf16(vf, pfA, oA1, 0, 0, 0); if (two) oB1 = __builtin_amdgcn_mfma_f32_32x32x16_bf16(vf, pfB, oB1, 0, 0, 0); }
        }
    }
    int klo = q0 - 128; if (klo < 0) klo = 0;
    int khi = q0 + (two ? 192 : 160); if (khi > kend) khi = kend;
    for (int k0 = klo; k0 < khi; k0 += 32) {
        const bool actA = (k0 <= q0 + 128), actB = two && (k0 >= q0 - 96);
        const int r0 = ring_row(k0);
        bf16x8 kf[4];
#pragma unroll
        for (int d0 = 0; d0 < 4; ++d0) kf[d0] = *(const LAS bf16x8*)(lds + AT_RK + sw_k(r0 + l31, 2 * d0 + hi));
        f32x16 pA = {}, pB = {};
        if (actA) {
#pragma unroll
            for (int d0 = 0; d0 < 4; ++d0) pA = __builtin_amdgcn_mfma_f32_32x32x16_bf16(kf[d0], qa[d0], pA, 0, 0, 0);
        }
        if (actB) {
#pragma unroll
            for (int d0 = 0; d0 < 4; ++d0) pB = __builtin_amdgcn_mfma_f32_32x32x16_bf16(kf[d0], qb[d0], pB, 0, 0, 0);
        }
        if (actA) at_softmax(pA, mA, lA, oA0, oA1, (float)(k0 - qposA + 4 * hi), nsl, true, (k0 + 31 - q0 > 128) || (q0 + 31 - k0 > 128), false);
        if (actB) at_softmax(pB, mB, lB, oB0, oB1, (float)(k0 - qposB + 4 * hi), nsl, true, (k0 - 1 - q0 > 128) || (q0 + 63 - k0 > 128), false);
#pragma unroll
        for (int st = 0; st < 2; ++st) {
            const bf16x8 pfA = at_pack(pA, st), pfB = at_pack(pB, st);
            const int row = r0 + 16 * st + vr;
#pragma unroll
            for (int dt = 0; dt < 2; ++dt) {
                const s16x4 lo = vtr(lds + AT_RV + sw_v(row, 4 * dt + vc) + vb), hh = vtr(lds + AT_RV + sw_v(row + 8, 4 * dt + vc) + vb);
                const bf16x8 vf = (bf16x8){lo[0], lo[1], lo[2], lo[3], hh[0], hh[1], hh[2], hh[3]};
                if (dt == 0) { if (actA) oA0 = __builtin_amdgcn_mfma_f32_32x32x16_bf16(vf, pfA, oA0, 0, 0, 0); if (actB) oB0 = __builtin_amdgcn_mfma_f32_32x32x16_bf16(vf, pfB, oB0, 0, 0, 0); }
                else { if (actA) oA1 = __builtin_amdgcn_mfma_f32_32x32x16_bf16(vf, pfA, oA1, 0, 0, 0); if (actB) oB1 = __builtin_amdgcn_mfma_f32_32x32x16_bf16(vf, pfB, oB1, 0, 0, 0); }
            }
        }
    }
    const float invA = 1.0f / half_sum(lA), invB = 1.0f / half_sum(lB);
    if (q0 >= 0 || l31 < 16) at_store(AO, qrowA, h, hi, oA0, oA1, invA);
    if (two) at_store(AO, qrowB, h, hi, oB0, oB1, invB);
}
__device__ __forceinline__ void at_dma_block(LAS unsigned char* lds, const bf16* PROJ, int rb, int kb, int kh, int wid, int lane) {
    const int cp = lane & 7;
#pragma unroll
    for (int i = 0; i < 2; ++i) {
        const int gI = wid + 8 * i, r0 = ((kb & 3) << 7) + 8 * gI, lr = r0 + (lane >> 3);
        const bf16* src = PROJ + (size_t)(rb + kb * 128 + 8 * gI + (lane >> 3)) * PJ + PJ_K + kh * 64;
        __builtin_amdgcn_global_load_lds((const unsigned*)(src + ((cp ^ ((lr >> 1) & 7)) << 3)), (LAS unsigned*)(lds + AT_RK + r0 * AT_ROWB), 16, 0, 0);
        __builtin_amdgcn_global_load_lds((const unsigned*)(src + (PJ_V - PJ_K) + ((cp ^ (((lr >> 1) & 1) << 2)) << 3)), (LAS unsigned*)(lds + AT_RV + r0 * AT_ROWB), 16, 0, 0);
    }
}
__device__ __forceinline__ void at_pool(const bf16* PROJ, bf16* DB, int kh, int p0, int nrows, int mb, int rb, int L, int tid) {
    switch (kh) {
        case 0: pool_items<1>(PROJ, DB, kh, p0, nrows, mb, rb, L, tid); break;
        case 1: pool_items<2>(PROJ, DB, kh, p0, nrows, mb, rb, L, tid); break;
        case 2: pool_items<4>(PROJ, DB, kh, p0, nrows, mb, rb, L, tid); break;
        default: pool_items<8>(PROJ, DB, kh, p0, nrows, mb, rb, L, tid); break;
    }
}
__device__ __forceinline__ void attn_group(LAS unsigned char* lds, const bf16* __restrict__ PROJ, bf16* __restrict__ AO, bf16* __restrict__ DB, const float* __restrict__ sink_l, int gidx) {
    int tid_ = threadIdx.x; asm volatile("" : "+v"(tid_));
    const int tid = tid_, lane = tid & 63, wid = __builtin_amdgcn_readfirstlane(tid >> 6);
    const int kh = gidx & 3, gq = gidx >> 2;
    int s, n0;
    if (gq < 16) { s = 0; n0 = 4 * gq; } else if (gq < 32) { s = 1; n0 = 4 * (gq - 16); } else { s = 2 + ((gq - 32) >> 3); n0 = 4 * ((gq - 32) & 7); }
    const int S = s < 2 ? 8192 : 4096, rb = s < 2 ? s * 8192 : 16384 + (s - 2) * 4096, mb = MREAL + 16 * s, L = S + 16, nb = S >> 7;
    if (wid < 2) {
        const int lr = 8 * wid + (lane >> 3), cp = lane & 7;
        const bf16* src = PROJ + (size_t)(mb + lr) * PJ + PJ_K + kh * 64;
        __builtin_amdgcn_global_load_lds((const unsigned*)(src + ((cp ^ ((lr >> 1) & 7)) << 3)), (LAS unsigned*)(lds + AT_MK + 8 * wid * AT_ROWB), 16, 0, 0);
        __builtin_amdgcn_global_load_lds((const unsigned*)(src + (PJ_V - PJ_K) + ((cp ^ (((lr >> 1) & 1) << 2)) << 3)), (LAS unsigned*)(lds + AT_MV + 8 * wid * AT_ROWB), 16, 0, 0);
    }
    if (n0 > 0) at_dma_block(lds, PROJ, rb, n0 - 1, kh, wid, lane);
    at_dma_block(lds, PROJ, rb, n0, kh, wid, lane);
    at_dma_block(lds, PROJ, rb, n0 + 1, kh, wid, lane);
    const int g = wid >> 1, h = kh * 4 + g;
    const float nsl = -__builtin_amdgcn_exp2f(-0.5f * (float)(h + 1)) * LOG2E, sinkl = sink_l[h] * LOG2E;
    asm volatile("s_waitcnt vmcnt(0)" ::: "memory");
    __syncthreads();
    if (n0 == 0) {
        if (wid < 4) { const int hm = kh * 4 + wid; attn_wave(lds, PROJ, AO, rb, mb, 128, hm, -__builtin_amdgcn_exp2f(-0.5f * (float)(hm + 1)) * LOG2E, sink_l[hm] * LOG2E, -16, 1, lane); }
        at_pool(PROJ, DB, kh, 0, 16, mb, rb, L, tid);
    }
    for (int i = 0; i < 4; ++i) {
        const int n = n0 + i;
        if (i > 0) { asm volatile("s_waitcnt vmcnt(0)" ::: "memory"); __syncthreads(); }
        if (n + 2 < nb && i < 3) at_dma_block(lds, PROJ, rb, n + 2, kh, wid, lane);
        int kend = 128 * (n + 2); if (kend > S) kend = S;
        attn_wave(lds, PROJ, AO, rb, mb, kend, h, nsl, sinkl, 128 * n + 64 * (wid & 1), 2, lane);
        at_pool(PROJ, DB, kh, 16 + 128 * n, 128, mb, rb, L, tid);
    }
    asm volatile("s_waitcnt vmcnt(0)" ::: "memory");
    __syncthreads();
}

#ifndef DO_P2
#define DO_P2 1
#endif
#ifndef DO_P1A
#define DO_P1A 1
#endif
#ifndef P1B_MODE
#define P1B_MODE 1
#endif
#ifndef REP_P2
#define REP_P2 1
#endif
#ifndef REP_P1A
#define REP_P1A 1
#endif
#ifndef STOP_AFTER
#define STOP_AFTER 0
#endif
__device__ __forceinline__ void dump_bf16(float* out, const bf16* buf, int pitch, int ncols, int gw, int NGW, int lane) {
    for (int r = gw; r < MREAL; r += NGW) for (int c = lane; c < 1024; c += 64) out[(size_t)r * 1024 + c] = __builtin_bit_cast(float, (unsigned)buf[(size_t)r * pitch + (c % ncols)] << 16);
}
#define STOP(k, buf, pitch, ncols) do { if (STOP_AFTER == (k)) { GSYNC(); if ((buf) != nullptr) dump_bf16(a.out, (const bf16*)(buf), pitch, ncols, gw, NGW, lane); return; } } while (0)
#ifndef USE_CG_SYNC
#define USE_CG_SYNC 1
#endif
__global__ void __launch_bounds__(512, 2) fwd_kernel(Args a) {
    extern __shared__ __attribute__((aligned(16))) unsigned char lds_raw[];
    LAS unsigned char* lds = (LAS unsigned char*)lds_raw;
    cg::grid_group grid = cg::this_grid();
    const int tid = threadIdx.x, lane = tid & 63, wave = __builtin_amdgcn_readfirstlane(tid >> 6);
    const int G = gridDim.x, bx = blockIdx.x;
    const int gw = bx * 8 + wave, NGW = G * 8;
    unsigned char* ws = a.ws;
    bf16* XB = (bf16*)(ws + WS_XB); bf16* RA = (bf16*)(ws + WS_A); bf16* RB = (bf16*)(ws + WS_B); bf16* DBUF = (bf16*)(ws + WS_B + SZ_XB);
    float* XFM = (float*)(ws + WS_XFM); bf16* MI = (bf16*)a.out;
    for (int u = tid; u < (LDS_BYTES - AT_CTL) / 4; u += 512) ((LAS unsigned*)(lds + AT_CTL))[u] = 0u;
    __syncthreads();
    XcdBarrier bar = xcd_barrier_post((unsigned*)(ws + WS_CTL) + 4096, (volatile LAS unsigned*)(lds + AT_CTL + 320) + 8);
#define GSYNC() do { xcd_barrier(bar); } while (0)
#define XF_ROW(r) ((r) < MREAL ? a.out + (size_t)(r) * D : XFM + (size_t)((r) - MREAL) * D)

    convert_weights(a, 0, lds, gw, NGW, wave, lane);
    for (int r = gw; r < MROWS; r += NGW) {
        const float* src = r < 16384 ? a.xp + (size_t)r * D : (r < MREAL ? a.xs + (size_t)(r - 16384) * D : a.meta + (size_t)((r - MREAL) & 15) * D);
        ln_row(src, nullptr, XB + (size_t)r * D, a.lneg, a.lneb, lane);
    }
    asm volatile("s_waitcnt vmcnt(0)" ::: "memory"); grid.sync();
    GSYNC();

#define PH_P1A(l) do { \
        if (DO_P1A) { pg8::Gemm g{XB, (const bf16*)(ws + WS_WIN), MREAL, 2048, D}; pg8::StaticOrder S; S.init(MREAL, 2048, G, bx); \
          pg8::EpiB<0> E{RA, PJ, nullptr, nullptr, 0, 0, QSCALE, 4}; \
          pg8::gemm_phase<pg8::EpiB<0>, pg8::StaticOrder, true, true>(lds, g, S, E); \
          thin_gemm<0>(lds, XB, (const bf16*)(ws + WS_WIN), 2048, D, ThinP{RA, PJ, nullptr, nullptr, 0, 0, nullptr, 0.f}); } \
        GSYNC(); \
} while (0)
#define PH_P2(l) do { \
        if ((l) == 0) { STOP(1, RA, PJ, 1024); } \
        if (DO_P2) { for (int gi = bx; gi < 256; gi += G) attn_group(lds, RA, RB, DBUF, a.sink + l * 16, gi); } \
        GSYNC(); \
} while (0)
#define PH_P1B(l) do { \
        if ((l) == 0) { STOP(2, RB, D, 1024); STOP(22, DBUF, 512, 512); } \
        { pg8::Gemm g{XB, (const bf16*)(ws + WS_WIN) + (size_t)2048 * D, MREAL, 2048, D}; pg8::StaticOrder S; S.init(MREAL, 2048, G, bx); \
          pg8::EpiB<P1B_MODE> E{RA, PJ, nullptr, nullptr, 0, 0, 1.f, 0}; \
          pg8::gemm_phase<pg8::EpiB<P1B_MODE>, pg8::StaticOrder, true, true>(lds, g, S, E); \
          thin_gemm<1>(lds, XB, (const bf16*)(ws + WS_WIN) + (size_t)2048 * D, 2048, D, ThinP{RA, PJ, nullptr, nullptr, 0, 0, nullptr, 0.f}); } \
        GSYNC(); \
} while (0)
#define PH_P3A(l) do { \
        if ((l) == 0) { STOP(3, RA, PJ, 1024); } \
        { pg8::Gemm g{RB, (const bf16*)(ws + WS_WA), MREAL, D, D}; pg8::StaticOrder S; S.init(MREAL, D, G, bx); \
          pg8::EpiB<3> E{MI, D, nullptr, RA, PJ, 0, 1.f, 0}; \
          pg8::gemm_phase<pg8::EpiB<3>, pg8::StaticOrder, true, true>(lds, g, S, E); \
          thin_gemm<3>(lds, RB, (const bf16*)(ws + WS_WA), D, D, ThinP{MI, D, nullptr, RA, PJ, 0, nullptr, 0.f}); } \
        GSYNC(); \
} while (0)
#define PH_P3B(l) do { \
        if ((l) == 0) { STOP(4, XB, D, 1024); } \
        { pg8::Gemm g{DBUF, (const bf16*)(ws + WS_WP), MREAL, D, 512}; pg8::StaticOrder S; S.init(MREAL, D, G, bx); \
          pg8::EpiB<4> E{MI, D, nullptr, RA, PJ, 1024, 1.f, 0}; \
          pg8::gemm_phase<pg8::EpiB<4>, pg8::StaticOrder, true, true>(lds, g, S, E); \
          thin_gemm<4>(lds, DBUF, (const bf16*)(ws + WS_WP), D, 512, ThinP{MI, D, nullptr, RA, PJ, 1024, nullptr, 0.f}); } \
        GSYNC(); \
} while (0)
#define PH_P4(l) do { \
        if ((l) == 0) { STOP(5, XB, D, 1024); } \
        { pg8::Gemm g{MI, (const bf16*)(ws + WS_WOUT), MREAL, D, D}; pg8::StaticOrder S; S.init(MREAL, D, G, bx); \
          pg8::EpiRes2 E{(float*)RA, XB, D, nullptr, ALPHA}; \
          pg8::gemm_phase<pg8::EpiRes2, pg8::StaticOrder, true, true>(lds, g, S, E); \
          thin_gemm<5>(lds, MI, (const bf16*)(ws + WS_WOUT), D, D, ThinP{nullptr, 0, nullptr, XB, D, 0, (float*)RA + (size_t)MREAL * D, ALPHA}); } \
        GSYNC(); \
} while (0)
#define PH_P5(l) do { \
        if ((l) == 0) { STOP(6, (const bf16*)nullptr, 0, 1); } \
        ln_rows<4, false>((const float*)RA, (const float*)RA + (size_t)MREAL * D, XB, a.ln1g + l * D, a.ln1b + l * D, gw, NGW, lane); \
        GSYNC(); \
} while (0)
#define PH_P6(l) do { \
        if ((l) == 0) { STOP(7, XB, D, 1024); } \
        { pg8::Gemm g{XB, (const bf16*)(ws + WS_W1), MREAL, DFF, D}; pg8::StaticOrder S; S.init(MREAL, DFF, G, bx); \
          pg8::EpiB<2> E{RA, DFF, a.b1 + l * DFF, nullptr, 0, 0, 1.f, 0}; \
          pg8::gemm_phase<pg8::EpiB<2>, pg8::StaticOrder, true, true>(lds, g, S, E); \
          thin_gemm<2>(lds, XB, (const bf16*)(ws + WS_W1), DFF, D, ThinP{RA, DFF, a.b1 + l * DFF, nullptr, 0, 0, nullptr, 0.f}); } \
        GSYNC(); \
} while (0)
#define PH_P7(l) do { \
        if ((l) == 0) { STOP(8, RA, DFF, 1024); } \
        { pg8::Gemm g{RA, (const bf16*)(ws + WS_W2), MREAL, D, DFF}; pg8::StaticOrder S; S.init(MREAL, D, G, bx); \
          pg8::EpiRes2 E{a.out, XB, D, a.b2 + l * D, ALPHA}; \
          pg8::gemm_phase<pg8::EpiRes2, pg8::StaticOrder, true, true>(lds, g, S, E); \
          thin_gemm<5>(lds, RA, (const bf16*)(ws + WS_W2), D, DFF, ThinP{nullptr, 0, a.b2 + l * D, XB, D, 0, XFM, ALPHA}); } \
        GSYNC(); \
} while (0)
#define PH_P8(l) do { \
        if ((l) == 0) { STOP(9, (const bf16*)nullptr, 0, 1); } \
        if ((l) + 1 < DEPTH) ln_rows<4, false>(a.out, XFM, XB, a.ln2g + l * D, a.ln2b + l * D, gw, NGW, lane); else ln_rows<4, true>(a.out, XFM, XB, a.ln2g + l * D, a.ln2b + l * D, gw, NGW, lane); \
        if (l + 1 < DEPTH) { convert_weights(a, l + 1, lds, gw, NGW, wave, lane); GSYNC(); } \
} while (0)
#define LAYER_BODY(l) do { PH_P1A(l); X_P1A(l); PH_P2(l); X_P2(l); PH_P1B(l); X_P1B(l); PH_P3A(l); X_P3A(l); PH_P3B(l); X_P3B(l); PH_P4(l); X_P4(l); PH_P5(l); X_P5(l); PH_P6(l); X_P6(l); PH_P7(l); X_P7(l); PH_P8(l); X_P8(l); } while (0)
#ifndef X_P1A
#define X_P1A(l) do {} while (0)
#endif
#ifndef X_P2
#define X_P2(l) do {} while (0)
#endif
#ifndef X_P1B
#define X_P1B(l) do {} while (0)
#endif
#ifndef X_P3A
#define X_P3A(l) do {} while (0)
#endif
#ifndef X_P3B
#define X_P3B(l) do {} while (0)
#endif
#ifndef X_P4
#define X_P4(l) do {} while (0)
#endif
#ifndef X_P5
#define X_P5(l) do {} while (0)
#endif
#ifndef X_P6
#define X_P6(l) do {} while (0)
#endif
#ifndef X_P7
#define X_P7(l) do {} while (0)
#endif
#ifndef X_P8
#define X_P8(l) do {} while (0)
#endif
    LAYER_BODY(0); LAYER_BODY(1); LAYER_BODY(2); LAYER_BODY(3);
}

extern "C" void kernel_launch(void* const* d_in, const int* in_sizes, int n_in, void* d_out, int out_size, void* d_ws, size_t ws_size, hipStream_t stream) {
    static int grid = 0;
    if (grid == 0) {
        if (n_in != 20 || out_size != MREAL * D || ws_size < WS_END) { fprintf(stderr, "kernel_launch: unexpected shapes: n_in %d out %d ws %zu (need %zu)\n", n_in, out_size, ws_size, (size_t)WS_END); grid = -1; return; }
        int dev = 0, cus = 0, per_cu = 0;
        hipGetDevice(&dev); hipDeviceGetAttribute(&cus, hipDeviceAttributeMultiprocessorCount, dev);
        if (hipFuncSetAttribute((const void*)fwd_kernel, hipFuncAttributeMaxDynamicSharedMemorySize, LDS_BYTES) != hipSuccess) { fprintf(stderr, "kernel_launch: hipFuncSetAttribute failed\n"); grid = -1; return; }
        hipOccupancyMaxActiveBlocksPerMultiprocessor(&per_cu, (const void*)fwd_kernel, 512, LDS_BYTES);
        (void)hipGetLastError();
        if (per_cu < 1) fprintf(stderr, "kernel_launch: occupancy query says %d blocks per CU\n", per_cu);
        grid = cus;
    }
    if (grid < 0) return;
    hipMemsetAsync((char*)d_ws + WS_CTL, 0, 1 * MiB, stream);
    Args a{};
    const float** f = (const float**)&a;
    for (int i = 0; i < 20; ++i) f[i] = (const float*)d_in[i];
    a.out = (float*)d_out; a.ws = (unsigned char*)d_ws;
    void* args[] = {&a};
    hipError_t e = hipLaunchCooperativeKernel((const void*)fwd_kernel, dim3(grid), dim3(512), args, LDS_BYTES, stream);
    if (e != hipSuccess) fprintf(stderr, "kernel_launch: cooperative launch failed: %s (grid %d)\n", hipGetErrorString(e), grid);
}
```
